# Optimizing an MI355X kernel written in HIP

```python
import jax, jax.numpy as jnp
from jax import lax
import numpy as np


D_MODEL = 1024
BATCH = 16
SEQ = 2048
DEPTH = 4
DEC_BATCH = 2
DEC_SEQ = 16384
PAST_LEN = 128

N_MIXERS = 3
N_MLA_LAYERS = (DEPTH + 2) // 3
N_RET_LAYERS = (DEPTH + 1) // 3
N_POOL_LAYERS = DEPTH // 3
NORM_EPS = 1e-6
ROPE_THETA = 10000.0

MLA_HEADS = 8
MLA_Q_LORA = 384
MLA_KV_LORA = 256
MLA_NOPE = 128
MLA_ROPE = 64
MLA_V = 128
MLA_QK = MLA_NOPE + MLA_ROPE
MLA_SCALE = MLA_QK ** -0.5
Q_BLOCK = 128

RET_HEADS = 4
RET_DK = D_MODEL // RET_HEADS
RET_DV = 2 * D_MODEL // RET_HEADS
RET_CHUNK = 128

POOL_WINDOWS = (2, 4, 8, 16)
N_POOL_GROUPS = len(POOL_WINDOWS)
POOL_GROUP = D_MODEL // N_POOL_GROUPS

D_FF = 4 * D_MODEL

kernel_name = 'hybrid_mla_retention_pool_encoder'


def rmsnorm(x, g):
    x32 = x.astype(jnp.float32)
    r = lax.rsqrt(jnp.mean(x32 * x32, axis=-1, keepdims=True) + NORM_EPS)
    return (x32 * r).astype(x.dtype) * g


def rope(x, theta):
    S, d = x.shape[1], x.shape[-1]
    half = d // 2
    inv = 1.0 / (theta ** (jnp.arange(half, dtype=jnp.float32) * 2.0 / d))
    ang = jnp.arange(S, dtype=jnp.float32)[:, None] * inv[None, :]
    cos = jnp.cos(ang)[:, None, :].astype(x.dtype)
    sin = jnp.sin(ang)[:, None, :].astype(x.dtype)
    x1, x2 = x[..., :half], x[..., half:]
    return jnp.concatenate([x1 * cos - x2 * sin, x1 * sin + x2 * cos], axis=-1)


def mla_mixer(h, w_dq, q_norm, w_uq, w_dkv, kv_norm, w_ukv, w_o):
    B, S, _ = h.shape
    cq = rmsnorm(h @ w_dq, q_norm)
    q = (cq @ w_uq).reshape(B, S, MLA_HEADS, MLA_QK)
    q = jnp.concatenate([q[..., :MLA_NOPE], rope(q[..., MLA_NOPE:], ROPE_THETA)], axis=-1)
    kv_a = h @ w_dkv
    c_kv = rmsnorm(kv_a[..., :MLA_KV_LORA], kv_norm)
    k_pe = rope(kv_a[..., None, MLA_KV_LORA:], ROPE_THETA)
    kv = (c_kv @ w_ukv).reshape(B, S, MLA_HEADS, MLA_NOPE + MLA_V)
    k = jnp.concatenate([kv[..., :MLA_NOPE],
                         jnp.broadcast_to(k_pe, (B, S, MLA_HEADS, MLA_ROPE))], axis=-1)
    v = kv[..., MLA_NOPE:]
    n_blk = S // Q_BLOCK
    qb = q.reshape(B, n_blk, Q_BLOCK, MLA_HEADS, MLA_QK).transpose(1, 0, 2, 3, 4)

    def attend(q_blk):
        s = jnp.einsum('bqhd,bkhd->bhqk', q_blk, k).astype(jnp.float32) * MLA_SCALE
        p = jax.nn.softmax(s, axis=-1).astype(v.dtype)
        return jnp.einsum('bhqk,bkhd->bqhd', p, v)

    o = lax.map(attend, qb)
    o = o.transpose(1, 0, 2, 3, 4).reshape(B, S, MLA_HEADS * MLA_V)
    return o @ w_o


def retention_scan(q, k, v, log_gamma):
    B, S, H, DK = q.shape
    DV = v.shape[-1]
    C = RET_CHUNK
    n = S // C

    def chunks(t):
        return t.reshape(B, n, C, H, t.shape[-1]).transpose(1, 0, 3, 2, 4)

    idx = jnp.arange(C, dtype=jnp.float32)
    diff = idx[:, None] - idx[None, :]
    lg = log_gamma[:, None, None]
    intra = jnp.where(diff >= 0, jnp.exp(jnp.maximum(diff, 0.0) * lg), 0.0).astype(q.dtype)
    q_dec = jnp.exp((idx + 1.0)[None, :] * log_gamma[:, None]).astype(q.dtype)[:, :, None]
    k_dec = jnp.exp((C - 1.0 - idx)[None, :] * log_gamma[:, None]).astype(q.dtype)[:, :, None]
    c_dec = jnp.exp(C * log_gamma).astype(q.dtype)[:, None, None]

    def step(state, blk):
        qc, kc, vc = blk
        att = jnp.einsum('bhid,bhjd->bhij', qc, kc) * intra
        out = (jnp.einsum('bhij,bhjv->bhiv', att, vc)
               + jnp.einsum('bhid,bhdv->bhiv', qc * q_dec, state))
        state = state * c_dec + jnp.einsum('bhjd,bhjv->bhdv', kc * k_dec, vc)
        return state, out

    init = jnp.zeros((B, H, DK, DV), q.dtype)
    _, out = lax.scan(step, init, (chunks(q), chunks(k), chunks(v)))
    return out.transpose(1, 0, 3, 2, 4).reshape(B, S, H, DV)


def retention_mixer(h, w_q, w_k, w_v, w_g, w_o, decay_fwd, decay_bwd):
    B, S, _ = h.shape
    q = rope((h @ w_q).reshape(B, S, RET_HEADS, RET_DK), ROPE_THETA)
    k = rope((h @ w_k).reshape(B, S, RET_HEADS, RET_DK), ROPE_THETA) * (RET_DK ** -0.5)
    v = (h @ w_v).reshape(B, S, RET_HEADS, RET_DV)
    lg_f = -jax.nn.softplus(decay_fwd.astype(jnp.float32))
    lg_b = -jax.nn.softplus(decay_bwd.astype(jnp.float32))
    o_f = retention_scan(q, k, v, lg_f)
    o_b = jnp.flip(retention_scan(jnp.flip(q, 1), jnp.flip(k, 1), jnp.flip(v, 1), lg_b), 1)
    o32 = (o_f + o_b).astype(jnp.float32)
    mu = jnp.mean(o32, axis=-1, keepdims=True)
    var = jnp.mean(jnp.square(o32 - mu), axis=-1, keepdims=True)
    o = ((o32 - mu) * lax.rsqrt(var + NORM_EPS)).astype(h.dtype).reshape(B, S, RET_HEADS * RET_DV)
    gate = jax.nn.silu(h @ w_g)
    return (gate * o) @ w_o


def pool_mixer(h, w_pool, scale):
    B, S, D = h.shape
    hg = h.reshape(B, S, N_POOL_GROUPS, POOL_GROUP)
    cs = jnp.cumsum(hg.astype(jnp.float32), axis=1)
    cs = jnp.concatenate([jnp.zeros((B, 1, N_POOL_GROUPS, POOL_GROUP), jnp.float32), cs], axis=1)
    t = jnp.arange(S)
    outs = []
    for g, w in enumerate(POOL_WINDOWS):
        lo = jnp.clip(t - w // 2, 0, S - 1)
        hi = jnp.clip(t + w // 2 - 1, 0, S - 1)
        csg = cs[:, :, g]
        total = jnp.take(csg, hi + 1, axis=1) - jnp.take(csg, lo, axis=1)
        cnt = (hi - lo + 1).astype(jnp.float32)
        outs.append(total / cnt[None, :, None])
    pooled = jnp.stack(outs, axis=2).astype(h.dtype) - hg
    mixed = jnp.einsum('bsgc,gcd->bsgd', pooled, w_pool).reshape(B, S, D)
    return mixed * scale


def sq_relu_mlp(h, w1, w2):
    return jnp.square(jax.nn.relu(h @ w1)) @ w2


def trunk(x, norm_mix, norm_ffn, mla_w_dq, mla_q_norm, mla_w_uq, mla_w_dkv, mla_kv_norm,
          mla_w_ukv, mla_w_o, ret_w_q, ret_w_k, ret_w_v, ret_w_g, ret_w_o, ret_decay_fwd,
          ret_decay_bwd, pool_w, pool_scale, mlp_w1, mlp_w2, final_norm):
    for i in range(DEPTH):
        kind, j = i % N_MIXERS, i // N_MIXERS
        h = rmsnorm(x, norm_mix[i])
        if kind == 0:
            x = x + mla_mixer(h, mla_w_dq[j], mla_q_norm[j], mla_w_uq[j], mla_w_dkv[j],
                              mla_kv_norm[j], mla_w_ukv[j], mla_w_o[j])
        elif kind == 1:
            x = x + retention_mixer(h, ret_w_q[j], ret_w_k[j], ret_w_v[j], ret_w_g[j],
                                    ret_w_o[j], ret_decay_fwd[j], ret_decay_bwd[j])
        else:
            x = x + pool_mixer(h, pool_w[j], pool_scale[j])
        x = x + sq_relu_mlp(rmsnorm(x, norm_ffn[i]), mlp_w1[i], mlp_w2[i])
    return rmsnorm(x, final_norm)


def setup_inputs(seed: int = 0) -> dict:
    key = jax.random.key(seed)
    ks = jax.random.split(key, 24)
    f32 = jnp.float32

    def nrm(k, shape, fan_in):
        return jax.random.normal(k, shape, f32) * (fan_in ** -0.5)

    def gain(k, shape):
        return 1.0 + 0.02 * jax.random.normal(k, shape, f32)

    target = -np.log(1.0 - 2.0 ** (-5.0 - np.arange(RET_HEADS)))
    raw = jnp.asarray(np.log(np.expm1(target)), dtype=f32)
    return {
        'x_prompt': jax.random.normal(ks[0], (BATCH, SEQ, D_MODEL), f32),
        'x_sample': jax.random.normal(ks[1], (DEC_BATCH, DEC_SEQ, D_MODEL), f32),
        'norm_mix': gain(ks[2], (DEPTH, D_MODEL)),
        'norm_ffn': gain(ks[3], (DEPTH, D_MODEL)),
        'mla_w_dq': nrm(ks[4], (N_MLA_LAYERS, D_MODEL, MLA_Q_LORA), D_MODEL),
        'mla_q_norm': gain(ks[5], (N_MLA_LAYERS, MLA_Q_LORA)),
        'mla_w_uq': nrm(ks[6], (N_MLA_LAYERS, MLA_Q_LORA, MLA_HEADS * MLA_QK), MLA_Q_LORA),
        'mla_w_dkv': nrm(ks[7], (N_MLA_LAYERS, D_MODEL, MLA_KV_LORA + MLA_ROPE), D_MODEL),
        'mla_kv_norm': gain(ks[8], (N_MLA_LAYERS, MLA_KV_LORA)),
        'mla_w_ukv': nrm(ks[9], (N_MLA_LAYERS, MLA_KV_LORA, MLA_HEADS * (MLA_NOPE + MLA_V)), MLA_KV_LORA),
        'mla_w_o': nrm(ks[10], (N_MLA_LAYERS, MLA_HEADS * MLA_V, D_MODEL), MLA_HEADS * MLA_V),
        'ret_w_q': nrm(ks[11], (N_RET_LAYERS, D_MODEL, D_MODEL), D_MODEL),
        'ret_w_k': nrm(ks[12], (N_RET_LAYERS, D_MODEL, D_MODEL), D_MODEL),
        'ret_w_v': nrm(ks[13], (N_RET_LAYERS, D_MODEL, 2 * D_MODEL), D_MODEL),
        'ret_w_g': nrm(ks[14], (N_RET_LAYERS, D_MODEL, 2 * D_MODEL), D_MODEL),
        'ret_w_o': nrm(ks[15], (N_RET_LAYERS, 2 * D_MODEL, D_MODEL), 2 * D_MODEL),
        'ret_decay_fwd': raw[None, :] + 0.05 * jax.random.normal(ks[16], (N_RET_LAYERS, RET_HEADS), f32),
        'ret_decay_bwd': raw[None, :] + 0.05 * jax.random.normal(ks[17], (N_RET_LAYERS, RET_HEADS), f32),
        'pool_w': nrm(ks[18], (N_POOL_LAYERS, N_POOL_GROUPS, POOL_GROUP, POOL_GROUP), POOL_GROUP),
        'pool_scale': gain(ks[19], (N_POOL_LAYERS, D_MODEL)),
        'mlp_w1': nrm(ks[20], (DEPTH, D_MODEL, D_FF), D_MODEL),
        'mlp_w2': nrm(ks[21], (DEPTH, D_FF, D_MODEL), D_FF),
        'final_norm': gain(ks[22], (D_MODEL,)),
    }


def reference(x_prompt, x_sample, norm_mix, norm_ffn, mla_w_dq, mla_q_norm, mla_w_uq,
              mla_w_dkv, mla_kv_norm, mla_w_ukv, mla_w_o, ret_w_q, ret_w_k, ret_w_v, ret_w_g,
              ret_w_o, ret_decay_fwd, ret_decay_bwd, pool_w, pool_scale, mlp_w1, mlp_w2,
              final_norm):
    y_prompt = trunk(x_prompt, norm_mix, norm_ffn, mla_w_dq, mla_q_norm, mla_w_uq, mla_w_dkv,
                     mla_kv_norm, mla_w_ukv, mla_w_o, ret_w_q, ret_w_k, ret_w_v, ret_w_g, ret_w_o,
                     ret_decay_fwd, ret_decay_bwd, pool_w, pool_scale, mlp_w1, mlp_w2, final_norm)
    y_sample = trunk(x_sample, norm_mix, norm_ffn, mla_w_dq, mla_q_norm, mla_w_uq, mla_w_dkv,
                     mla_kv_norm, mla_w_ukv, mla_w_o, ret_w_q, ret_w_k, ret_w_v, ret_w_g, ret_w_o,
                     ret_decay_fwd, ret_decay_bwd, pool_w, pool_scale, mlp_w1, mlp_w2, final_norm)
    return (y_prompt, y_sample)
```

```cpp
#include <hip/hip_runtime.h>
#include <hip/hip_cooperative_groups.h>
#include <cstdio>
#include <cstdint>
#include <cstring>
namespace cg = cooperative_groups;

typedef unsigned short bf16;
using bf16x8 = __attribute__((ext_vector_type(8))) short;
using s16x4  = __attribute__((ext_vector_type(4))) short;
using f32x16 = __attribute__((ext_vector_type(16))) float;
using f32x4  = __attribute__((ext_vector_type(4))) float;
using u32x4  = __attribute__((ext_vector_type(4))) unsigned;
using u32x2  = __attribute__((ext_vector_type(2))) unsigned;
typedef __bf16 bf2_t __attribute__((ext_vector_type(2)));
typedef float f2_t __attribute__((ext_vector_type(2)));
#define DI __device__ __forceinline__
#define MFMA(a, b, c) __builtin_amdgcn_mfma_f32_32x32x16_bf16((a), (b), (c), 0, 0, 0)

constexpr int T = 65536, TH = 32768, TQ = 16384;
constexpr size_t MiB = (size_t)1 << 20;
constexpr long MLA_WUQ = 768L * 1024, MLA_WUKV = MLA_WUQ + 1536L * 384, MLA_WO = MLA_WUKV + 2048L * 256, MLA_SZ = MLA_WO + 1024L * 1024;
constexpr long WB_RET = 2 * MLA_SZ, RET_WG = 4096L * 1024, RET_WO = RET_WG + 2048L * 1024, RET_SZ = RET_WO + 1024L * 2048;
constexpr long WB_POOL = WB_RET + RET_SZ, POOL_SZ = 4L * 256 * 256;
constexpr long WB_MLP = WB_POOL + POOL_SZ, MLP_W2 = 4096L * 1024, MLP_SZ = 2 * MLP_W2;
constexpr size_t OFF_TABM = 97 * MiB, OFF_TABR = 101 * MiB, OFF_S = 117 * MiB;
constexpr int LDT = 72;
constexpr int NT = 512;
constexpr int SMEM_BYTES = 4 * 256 * LDT * 2;

struct Job { const float* src; long long dst; int K, N, perm, pad; };
struct Params {
  const float* in[23];
  float* out;
  char* ws;
  Job jobs[27];
  int njobs;
  int pad;
};

DI unsigned pk2(float lo, float hi) { f2_t v = {lo, hi}; return __builtin_bit_cast(unsigned, __builtin_convertvector(v, bf2_t)); }
DI bf16 tobf(float x) { return (bf16)(pk2(x, 0.f) & 0xffffu); }
DI float bf2f(bf16 b) { return __uint_as_float(((unsigned)b) << 16); }
typedef const Params __attribute__((address_space(4)))* KP;
DI KP kargs() { KP k = (KP)__builtin_amdgcn_kernarg_segment_ptr(); asm volatile("" : "+s"(k)); return k; }
DI int lbid() { int b = blockIdx.x; asm volatile("" : "+s"(b)); return b; }
DI int ltid() { int t = threadIdx.x; asm volatile("" : "+v"(t)); return t; }
constexpr size_t OFF_BAR = 96 * MiB;
DI void gsync(unsigned& gen) {
  __syncthreads();
  const int t = ltid();
  if (t == 0) {
    KP k = kargs();
    unsigned* bar = (unsigned*)(k->ws + OFF_BAR);
    __builtin_amdgcn_fence(__ATOMIC_RELEASE, "agent");
    asm volatile("s_waitcnt vmcnt(0)" ::: "memory");
    gen += 1;
    const unsigned grp = blockIdx.x & 15u, gsize = (gridDim.x - grp + 15u) >> 4;
    if (__hip_atomic_fetch_add(bar + 64 * (1 + grp), 1u, __ATOMIC_RELAXED, __HIP_MEMORY_SCOPE_AGENT) + 1 == gen * gsize) {
      if (__hip_atomic_fetch_add(bar, 1u, __ATOMIC_RELAXED, __HIP_MEMORY_SCOPE_AGENT) + 1 == gen * 16u) {
        for (int g2 = 0; g2 < 16; ++g2) __hip_atomic_store(bar + 64 * (17 + g2), gen, __ATOMIC_RELAXED, __HIP_MEMORY_SCOPE_AGENT);
      }
    }
    while (__hip_atomic_load(bar + 64 * (17 + grp), __ATOMIC_RELAXED, __HIP_MEMORY_SCOPE_AGENT) < gen) __builtin_amdgcn_s_sleep(1);
    __builtin_amdgcn_fence(__ATOMIC_ACQUIRE, "agent");
    asm volatile("s_waitcnt vmcnt(0)" ::: "memory");
  }
  __syncthreads();
}
template <int K> DI float swz(float v) { return __int_as_float(__builtin_amdgcn_ds_swizzle(__float_as_int(v), 0x1F | (K << 10))); }
DI float half_sum(float v) { auto rr = __builtin_amdgcn_permlane32_swap(__float_as_uint(v), __float_as_uint(v), false, false); return __uint_as_float(rr[0]) + __uint_as_float(rr[1]); }
DI float half_max(float v) { auto rr = __builtin_amdgcn_permlane32_swap(__float_as_uint(v), __float_as_uint(v), false, false); return fmaxf(__uint_as_float(rr[0]), __uint_as_float(rr[1])); }
DI float wave_sum(float v) {
  v += swz<1>(v); v += swz<2>(v); v += swz<4>(v); v += swz<8>(v); v += swz<16>(v);
  return half_sum(v);
}
DI float neg_softplus(float x) { return -(fmaxf(x, 0.f) + log1pf(expf(-fabsf(x)))); }

template <bool PERM>
DI void gemm256_mainloop(f32x16 (&acc)[4][2], const bf16* A, long lda, const bf16* B, long ldb, int K, bf16* lds, int tid,
                         u32x4 (&ra)[4], u32x4 (&rb)[4], bool pre) {
  const int lane = tid & 63, wid = tid >> 6, r = lane & 31, h = lane >> 5, wm = wid >> 2, wn = wid & 3;
  bf16* As = lds;
  bf16* Bs = lds + 2 * 256 * LDT;
  const int lrow = tid >> 3, lk = (tid & 7) * 8;
  const int lrb = PERM ? (((lrow & 1) << 5) | (lrow >> 1)) : lrow;
  const unsigned oa = (unsigned)((lrow * (int)lda + lk) * 2), ob = (unsigned)((lrow * (int)ldb + lk) * 2);
  const char* Ab = (const char*)A;
  const char* Bb = (const char*)B;
  const int ns = K >> 6;
  if (!pre) {
#pragma unroll
    for (int i = 0; i < 4; ++i) { ra[i] = *(const u32x4*)(Ab + (size_t)(64 * i) * lda * 2 + oa); rb[i] = *(const u32x4*)(Bb + (size_t)(64 * i) * ldb * 2 + ob); }
  }
#pragma unroll
  for (int i = 0; i < 4; ++i) { *(u32x4*)(As + (lrow + 64 * i) * LDT + lk) = ra[i]; *(u32x4*)(Bs + (lrb + 64 * i) * LDT + lk) = rb[i]; }
  if (ns > 1) {
#pragma unroll
    for (int i = 0; i < 4; ++i) { ra[i] = *(const u32x4*)(Ab + 128 + (size_t)(64 * i) * lda * 2 + oa); rb[i] = *(const u32x4*)(Bb + 128 + (size_t)(64 * i) * ldb * 2 + ob); }
  }
  __syncthreads();
  for (int s = 0; s < ns; ++s) {
    const int cur = s & 1;
    const bf16* Ac = As + cur * 256 * LDT + (wm * 128 + r) * LDT + h * 8;
    const bf16* Bc = Bs + cur * 256 * LDT + (wn * 64 + r) * LDT + h * 8;
    const int nbuf = (cur ^ 1) * 256 * LDT;
    const size_t ko = (size_t)(s + 2) * 128;
#pragma unroll
    for (int ks = 0; ks < 4; ++ks) {
      bf16x8 a[4], b[2];
#pragma unroll
      for (int mi = 0; mi < 4; ++mi) a[mi] = *(const bf16x8*)(Ac + mi * 32 * LDT + ks * 16);
#pragma unroll
      for (int ni = 0; ni < 2; ++ni) b[ni] = *(const bf16x8*)(Bc + ni * 32 * LDT + ks * 16);
#pragma unroll
      for (int mi = 0; mi < 4; ++mi)
#pragma unroll
        for (int ni = 0; ni < 2; ++ni) acc[mi][ni] = MFMA(a[mi], b[ni], acc[mi][ni]);
      if (ks == 1 && s + 1 < ns) {
#pragma unroll
        for (int i = 0; i < 4; ++i) *(u32x4*)(As + nbuf + (lrow + 64 * i) * LDT + lk) = ra[i];
        if (s + 2 < ns) {
#pragma unroll
          for (int i = 0; i < 4; ++i) ra[i] = *(const u32x4*)(Ab + ko + (size_t)(64 * i) * lda * 2 + oa);
        }
      }
      if (ks == 2 && s + 1 < ns) {
#pragma unroll
        for (int i = 0; i < 4; ++i) *(u32x4*)(Bs + nbuf + (lrb + 64 * i) * LDT + lk) = rb[i];
        if (s + 2 < ns) {
#pragma unroll
          for (int i = 0; i < 4; ++i) rb[i] = *(const u32x4*)(Bb + ko + (size_t)(64 * i) * ldb * 2 + ob);
        }
      }
    }
    __syncthreads();
  }
}
template <int NW>
DI void gemm128_mainloop(f32x16 (&acc)[2][2], const bf16* A, long lda, const bf16* B0, long ldb0, const bf16* B1, long ldb1,
                         int K, bf16* lds, int tid, int wn0) {
  const int lane = tid & 63, wid = tid >> 6, r = lane & 31, h = lane >> 5, wm = wid >> 2, wn = (wid & 3) - wn0;
  const bool act = wn >= 0 && wn < NW;
  constexpr int NBR = 64 * NW;
  bf16* As = lds;
  bf16* Bs = lds + 2 * 128 * LDT;
  const int lrow = tid >> 3, lk = (tid & 7) * 8;
  const unsigned oa = (unsigned)((lrow * (int)lda + lk) * 2), ob0 = (unsigned)((lrow * (int)ldb0 + lk) * 2), ob1 = (unsigned)((lrow * (int)ldb1 + lk) * 2);
  const char* Ab = (const char*)A;
  const char* B0b = (const char*)B0;
  const char* B1b = (const char*)B1;
  u32x4 ra0[2], rb0[NW], ra1[2], rb1[NW];
#define CH_LOAD(RA, RB, ST) do { const size_t ko_ = (size_t)(ST) * 128; \
    _Pragma("unroll") for (int i = 0; i < 2; ++i) RA[i] = *(const u32x4*)(Ab + ko_ + (size_t)(64 * i) * lda * 2 + oa); \
    _Pragma("unroll") for (int i = 0; i < NW; ++i) RB[i] = (i < 2) ? *(const u32x4*)(B0b + ko_ + (size_t)(64 * i) * ldb0 * 2 + ob0) \
                                                                 : *(const u32x4*)(B1b + ko_ + (size_t)(64 * (i - 2)) * ldb1 * 2 + ob1); } while (0)
#define CH_STORE(RA, RB, BUF) do { \
    _Pragma("unroll") for (int i = 0; i < 2; ++i) *(u32x4*)(As + (BUF) * 128 * LDT + (lrow + 64 * i) * LDT + lk) = RA[i]; \
    _Pragma("unroll") for (int i = 0; i < NW; ++i) *(u32x4*)(Bs + (BUF) * NBR * LDT + (lrow + 64 * i) * LDT + lk) = RB[i]; } while (0)
#define CH_COMPUTE(CUR) do { if (act) { \
      const bf16* Ac = As + (CUR) * 128 * LDT + (wm * 64 + r) * LDT + h * 8; \
      const bf16* Bc = Bs + (CUR) * NBR * LDT + (wn * 64 + r) * LDT + h * 8; \
      _Pragma("unroll") for (int ks = 0; ks < 4; ++ks) { \
        const bf16x8 a0 = *(const bf16x8*)(Ac + ks * 16), a1 = *(const bf16x8*)(Ac + 32 * LDT + ks * 16); \
        const bf16x8 b0 = *(const bf16x8*)(Bc + ks * 16), b1 = *(const bf16x8*)(Bc + 32 * LDT + ks * 16); \
        acc[0][0] = MFMA(a0, b0, acc[0][0]); acc[0][1] = MFMA(a0, b1, acc[0][1]); \
        acc[1][0] = MFMA(a1, b0, acc[1][0]); acc[1][1] = MFMA(a1, b1, acc[1][1]); } } } while (0)
  const int ns = K >> 6;
  CH_LOAD(ra0, rb0, 0);
  CH_LOAD(ra1, rb1, 1);
  CH_STORE(ra0, rb0, 0);
  __syncthreads();
  for (int s = 0; s < ns; s += 2) {
    if (s + 2 < ns) CH_LOAD(ra0, rb0, s + 2);
    CH_COMPUTE(0);
    CH_STORE(ra1, rb1, 1);
    __syncthreads();
    if (s + 3 < ns) CH_LOAD(ra1, rb1, s + 3);
    CH_COMPUTE(1);
    if (s + 2 < ns) CH_STORE(ra0, rb0, 0);
    __syncthreads();
  }
#undef CH_COMPUTE
#undef CH_LOAD
#undef CH_STORE
}
DI void zero_acc(f32x16 (&acc)[2][2]) {
#pragma unroll
  for (int a = 0; a < 2; ++a)
#pragma unroll
    for (int b = 0; b < 2; ++b)
#pragma unroll
      for (int i = 0; i < 16; ++i) acc[a][b][i] = 0.f;
}
template <bool PERM = false, class Epi>
DI void gemm_tile(const bf16* A, long lda, const bf16* B, long ldb, int K, int m0, int n0, bf16* lds, Epi epi) {
  f32x16 acc[4][2];
#pragma unroll
  for (int a = 0; a < 4; ++a)
#pragma unroll
    for (int b = 0; b < 2; ++b)
#pragma unroll
      for (int i = 0; i < 16; ++i) acc[a][b][i] = 0.f;
  int tid = threadIdx.x;
  asm volatile("" : "+v"(tid));
  u32x4 ra[4], rb[4];
  gemm256_mainloop<PERM>(acc, A + (long)m0 * lda, lda, B + (long)n0 * ldb, ldb, K, lds, tid, ra, rb, false);
  const int wid = tid >> 6;
  epi(acc, m0 + (wid >> 2) * 128, n0 + (wid & 3) * 64, tid & 31, (tid >> 5) & 1);
}
template <bool PERM = false, class Map, class Epi>
DI void gemm_phase(const bf16* A, long lda, const bf16* B, long ldb, int K, int lim, int nb, bf16* lds, Map map, Epi epi) {
  int q = lbid() >> 3;
  const int qs = nb >> 3;
  if (q >= lim) return;
  int tid = ltid();
  u32x4 ra[4], rb[4];
  long aoff, boff; int mrow, ncol;
  map(q, aoff, boff, mrow, ncol);
  {
    const int lrow = tid >> 3, lk = (tid & 7) * 8;
    const unsigned oa = (unsigned)((lrow * (int)lda + lk) * 2), ob = (unsigned)((lrow * (int)ldb + lk) * 2);
    const char* Ab = (const char*)(A + aoff); const char* Bb = (const char*)(B + boff);
#pragma unroll
    for (int i = 0; i < 4; ++i) { ra[i] = *(const u32x4*)(Ab + (size_t)(64 * i) * lda * 2 + oa); rb[i] = *(const u32x4*)(Bb + (size_t)(64 * i) * ldb * 2 + ob); }
  }
  for (;;) {
    f32x16 acc[4][2];
#pragma unroll
    for (int a = 0; a < 4; ++a)
#pragma unroll
      for (int b = 0; b < 2; ++b)
#pragma unroll
        for (int i = 0; i < 16; ++i) acc[a][b][i] = 0.f;
    asm volatile("" : "+v"(tid));
    gemm256_mainloop<PERM>(acc, A + aoff, lda, B + boff, ldb, K, lds, tid, ra, rb, true);
    const int qn = q + qs;
    const bool more = qn < lim;
    const int mrow0 = mrow, ncol0 = ncol;
    if (more) {
      map(qn, aoff, boff, mrow, ncol);
      const int lrow = tid >> 3, lk = (tid & 7) * 8;
      const unsigned oa = (unsigned)((lrow * (int)lda + lk) * 2), ob = (unsigned)((lrow * (int)ldb + lk) * 2);
      const char* Ab = (const char*)(A + aoff); const char* Bb = (const char*)(B + boff);
#pragma unroll
      for (int i = 0; i < 4; ++i) { ra[i] = *(const u32x4*)(Ab + (size_t)(64 * i) * lda * 2 + oa); rb[i] = *(const u32x4*)(Bb + (size_t)(64 * i) * ldb * 2 + ob); }
    }
    const int wid = tid >> 6;
    epi(acc, mrow0 + (wid >> 2) * 128, ncol0 + (wid & 3) * 64, tid & 31, (tid >> 5) & 1);
    if (!more) break;
    q = qn;
  }
}
#define EPI_LOOP _Pragma("unroll") for (int mi = 0; mi < 4; ++mi) _Pragma("unroll") for (int ni = 0; ni < 2; ++ni) _Pragma("unroll") for (int g = 0; g < 4; ++g)
#define EPI_LOOP_PAIR _Pragma("unroll") for (int mi = 0; mi < 4; ++mi) _Pragma("unroll") for (int g = 0; g < 4; ++g)
#define CH_LOOP _Pragma("unroll") for (int mi = 0; mi < 2; ++mi) _Pragma("unroll") for (int ni = 0; ni < 2; ++ni) _Pragma("unroll") for (int g = 0; g < 4; ++g)
#define TILE_LOOP(NTM, NTN) for (int q_ = lbid() >> 3; q_ < ((NTM) >> 3) * (NTN); q_ += (nb >> 3))
#define TILE_TM(NTN) ((int)(blockIdx.x & 7) + 8 * (q_ / (NTN)))
#define TILE_TN(NTN) (q_ % (NTN))
#define MAP_STD(NTN, LDA, LDB) [&](int q_, long& ao, long& bo, int& mr, int& nc) { mr = TILE_TM(NTN) * 256; nc = TILE_TN(NTN) * 256; ao = (long)mr * (LDA); bo = (long)nc * (LDB); }
#define MAP_2D(NTN, LDA, LDB) [&](int q_, long& ao, long& bo, int& mr, int& nc) { mr = TILE_TM2(NTN) * 256; nc = TILE_TN2(NTN) * 256; ao = (long)mr * (LDA); bo = (long)nc * (LDB); }
#define TILE_TM2(NTN) ((int)(blockIdx.x & 7) + 8 * (((q_ >> 5) / ((NTN) >> 2)) * 8 + ((q_ & 31) >> 2)))
#define TILE_TN2(NTN) ((((q_ >> 5) % ((NTN) >> 2)) << 2) + (q_ & 3))

DI void epi_residual(f32x16 (&acc)[4][2], const float* xin, float* xout, const float* scale, int mw, int nw, int r, int h) {
  f2_t sc = {1.f, 1.f};
  if (scale) sc = *(const f2_t*)(scale + nw + 2 * r);
#pragma unroll
  for (int mi = 0; mi < 4; ++mi) {
    f2_t t[16];
#pragma unroll
    for (int k = 0; k < 16; ++k) t[k] = *(const f2_t*)(xin + (long)(mw + mi * 32 + (k >> 2) * 8 + h * 4 + (k & 3)) * 1024 + nw + 2 * r);
#pragma unroll
    for (int k = 0; k < 16; ++k) {
      f2_t o = {t[k][0] + acc[mi][0][k] * sc[0], t[k][1] + acc[mi][1][k] * sc[1]};
      *(f2_t*)(xout + (long)(mw + mi * 32 + (k >> 2) * 8 + h * 4 + (k & 3)) * 1024 + nw + 2 * r) = o;
    }
  }
}

template <int R, bool TO_BF16>
DI void rmsnorm_rows(const float* x, const float* gain, bf16* hout, float* fout, int nrows) {
  const int tid = ltid(), lane = tid & 63;
  const int wv = (blockIdx.x * NT + tid) >> 6, nw = gridDim.x * (NT / 64);
  for (int row = wv; row < nrows; row += R * nw) {
    f32x4 v[R][4];
#pragma unroll
    for (int q = 0; q < R; ++q) {
      const int rr = (row + q * nw < nrows) ? row + q * nw : row;
      const f32x4* xr = (const f32x4*)(x + (long)rr * 1024);
#pragma unroll
      for (int i = 0; i < 4; ++i) v[q][i] = xr[lane + 64 * i];
    }
    f32x4 gg[4];
#pragma unroll
    for (int i = 0; i < 4; ++i) gg[i] = ((const f32x4*)gain)[lane + 64 * i];
#pragma unroll
    for (int q = 0; q < R; ++q) {
      const bool valid = row + q * nw < nrows;
      const int rr = valid ? row + q * nw : row;
      float ss = 0.f;
#pragma unroll
      for (int i = 0; i < 4; ++i) ss += v[q][i][0] * v[q][i][0] + v[q][i][1] * v[q][i][1] + v[q][i][2] * v[q][i][2] + v[q][i][3] * v[q][i][3];
      ss = wave_sum(ss);
      const float rs = rsqrtf(ss * (1.f / 1024.f) + 1e-6f);
#pragma unroll
      for (int i = 0; i < 4; ++i) {
        const f32x4 o = {v[q][i][0] * rs * gg[i][0], v[q][i][1] * rs * gg[i][1], v[q][i][2] * rs * gg[i][2], v[q][i][3] * rs * gg[i][3]};
        if (!valid) continue;
        if (TO_BF16) {
          u32x2 ob = {pk2(o[0], o[1]), pk2(o[2], o[3])};
          *(u32x2*)(hout + (long)rr * 1024 + (lane + 64 * i) * 4) = ob;
        } else {
          *(f32x4*)(fout + (long)rr * 1024 + (lane + 64 * i) * 4) = o;
        }
      }
    }
  }
}
DI void phase_rmsnorm_bf16(const float* x, const float* gain, bf16* hout, int nrows) { rmsnorm_rows<4, true>(x, gain, hout, nullptr, nrows); }
DI void phase_final_norm(float* x, const float* gain, int nrows) { rmsnorm_rows<4, false>(x, gain, nullptr, x, nrows); }
DI void phase_mla_rownorm(bf16* ca, const float* qg, const float* kvg, int nrows) {
  const int tid = ltid(), lane = tid & 63;
  const int wv = (blockIdx.x * NT + tid) >> 6, nw = gridDim.x * (NT / 64);
  constexpr int R = 4;
  for (int row = wv; row < nrows; row += R * nw) {
    bf16x8 va[R], vb[R];
#pragma unroll
    for (int q = 0; q < R; ++q) {
      const int rr = (row + q * nw < nrows) ? row + q * nw : row;
      const bf16* rp = ca + (long)rr * 640;
      va[q] = *(const bf16x8*)(rp + (lane < 48 ? lane : 0) * 8);
      vb[q] = *(const bf16x8*)(rp + 384 + (lane & 31) * 8);
    }
#pragma unroll
    for (int q = 0; q < R; ++q) {
      const bool valid = row + q * nw < nrows;
      bf16* rp = ca + (long)(valid ? row + q * nw : row) * 640;
      float a[8], b[8];
      float s1 = 0.f, s2 = 0.f;
#pragma unroll
      for (int i = 0; i < 8; ++i) {
        a[i] = bf2f((bf16)va[q][i]); b[i] = bf2f((bf16)vb[q][i]);
        if (lane < 48) s1 += a[i] * a[i];
        if (lane < 32) s2 += b[i] * b[i];
      }
      s1 = wave_sum(s1); s2 = wave_sum(s2);
      const float r1 = rsqrtf(s1 * (1.f / 384.f) + 1e-6f), r2 = rsqrtf(s2 * (1.f / 256.f) + 1e-6f);
      if (valid && lane < 48) {
        const float* g = qg + lane * 8;
        u32x4 o = {pk2(a[0] * r1 * g[0], a[1] * r1 * g[1]), pk2(a[2] * r1 * g[2], a[3] * r1 * g[3]), pk2(a[4] * r1 * g[4], a[5] * r1 * g[5]), pk2(a[6] * r1 * g[6], a[7] * r1 * g[7])};
        *(u32x4*)(rp + lane * 8) = o;
      }
      if (valid && lane < 32) {
        const float* g = kvg + lane * 8;
        u32x4 o = {pk2(b[0] * r2 * g[0], b[1] * r2 * g[1]), pk2(b[2] * r2 * g[2], b[3] * r2 * g[3]), pk2(b[4] * r2 * g[4], b[5] * r2 * g[5]), pk2(b[6] * r2 * g[6], b[7] * r2 * g[7])};
        *(u32x4*)(rp + 384 + lane * 8) = o;
      }
    }
  }
}
DI void phase_onorm(bf16* of, const bf16* ob, int ntok) {
  const int tid = ltid(), lane = tid & 63;
  const int wv = (blockIdx.x * NT + tid) >> 6, nw = gridDim.x * (NT / 64);
  constexpr int R = 4;
  for (int it = wv; it < ntok * 4; it += R * nw) {
    bf16x8 v1[R], v2[R];
#pragma unroll
    for (int q = 0; q < R; ++q) {
      const int ii = (it + q * nw < ntok * 4) ? it + q * nw : it;
      const long off = (long)ii * 512 + lane * 8;
      v1[q] = *(const bf16x8*)(of + off); v2[q] = *(const bf16x8*)(ob + off);
    }
#pragma unroll
    for (int q = 0; q < R; ++q) {
      const bool valid = it + q * nw < ntok * 4;
      const long off = (long)(valid ? it + q * nw : it) * 512 + lane * 8;
      float a[8];
      float s = 0.f;
#pragma unroll
      for (int i = 0; i < 8; ++i) { a[i] = bf2f((bf16)v1[q][i]) + bf2f((bf16)v2[q][i]); s += a[i]; }
      const float mu = wave_sum(s) * (1.f / 512.f);
      float qq = 0.f;
#pragma unroll
      for (int i = 0; i < 8; ++i) { a[i] -= mu; qq += a[i] * a[i]; }
      const float rs = rsqrtf(wave_sum(qq) * (1.f / 512.f) + 1e-6f);
      u32x4 o = {pk2(a[0] * rs, a[1] * rs), pk2(a[2] * rs, a[3] * rs), pk2(a[4] * rs, a[5] * rs), pk2(a[6] * rs, a[7] * rs)};
      if (valid) *(u32x4*)(of + off) = o;
    }
  }
}
DI void phase_pool(const bf16* hh, bf16* pl, int ntok, int S) {
  const long total = (long)ntok * 128;
  const int tid = ltid();
  for (long it = (long)blockIdx.x * NT + tid; it < total; it += (long)gridDim.x * NT) {
    const int t = (int)(it >> 7), ch = (int)(it & 127);
    const int s = t & (S - 1), sb = t - s;
    const int w = 2 << (ch >> 5);
    int lo = s - (w >> 1); if (lo < 0) lo = 0;
    int hi = s + (w >> 1) - 1; if (hi > S - 1) hi = S - 1;
    bf16x8 v[16];
#pragma unroll
    for (int k = 0; k < 16; ++k) {
      const int rr = (lo + k <= hi) ? lo + k : hi;
      if (k < w) v[k] = *(const bf16x8*)(hh + (long)(sb + rr) * 1024 + ch * 8);
      else v[k] = (bf16x8){0, 0, 0, 0, 0, 0, 0, 0};
    }
    const bf16x8 c = *(const bf16x8*)(hh + (long)t * 1024 + ch * 8);
    float acc[8];
#pragma unroll
    for (int i = 0; i < 8; ++i) acc[i] = 0.f;
#pragma unroll
    for (int k = 0; k < 16; ++k) {
      if (lo + k <= hi) {
#pragma unroll
        for (int i = 0; i < 8; ++i) acc[i] += bf2f((bf16)v[k][i]);
      }
    }
    const float ic = 1.f / (float)(hi - lo + 1);
    float o[8];
#pragma unroll
    for (int i = 0; i < 8; ++i) o[i] = acc[i] * ic - bf2f((bf16)c[i]);
    u32x4 ov = {pk2(o[0], o[1]), pk2(o[2], o[3]), pk2(o[4], o[5]), pk2(o[6], o[7])};
    *(u32x4*)(pl + (long)t * 1024 + ch * 8) = ov;
  }
}

DI void sincos_d(double x, float& s, float& c) {
  const double x2 = x * x;
  double ts = 1.0, tc = 1.0;
#pragma unroll
  for (int k = 14; k >= 1; --k) {
    ts = 1.0 - ts * x2 * (1.0 / (double)((2 * k) * (2 * k + 1)));
    tc = 1.0 - tc * x2 * (1.0 / (double)((2 * k - 1) * (2 * k)));
  }
  s = (float)(x * ts); c = (float)tc;
}
DI void phase_prologue(KP pp, float* ldsf) {
  const int tid = ltid();
  bf16* WB = (bf16*)pp->ws;
  for (int j = 0; j < pp->njobs; ++j) {
    const float* src = pp->jobs[j].src;
    bf16* dst = WB + pp->jobs[j].dst;
    const int K = pp->jobs[j].K, N = pp->jobs[j].N, perm = pp->jobs[j].perm;
    const int tk = K >> 6, tn = N >> 6;
    for (int tile = blockIdx.x; tile < tk * tn; tile += gridDim.x) {
      const int k0 = (tile % tk) * 64, n0 = (tile / tk) * 64;
#pragma unroll 4
      for (int i = 0; i < 8; ++i) {
        const int ky = (tid >> 6) + 8 * i, nx = tid & 63;
        ldsf[ky * 65 + nx] = src[(long)(k0 + ky) * N + n0 + nx];
      }
      __syncthreads();
#pragma unroll 4
      for (int i = 0; i < 8; ++i) {
        const int ny = (tid >> 6) + 8 * i, kx = tid & 63;
        int n = n0 + ny;
        if (perm) { const int d = n & 255; n = (n & ~255) | (((d >> 5) & 3) << 6) | ((d >> 7) << 5) | (d & 31); }
        dst[(long)n * K + k0 + kx] = tobf(ldsf[kx * 65 + ny]);
      }
      __syncthreads();
    }
  }
  float2* tabM = (float2*)(pp->ws + OFF_TABM);
  float2* tabR = (float2*)(pp->ws + OFF_TABR);
  const long nM = 16384L * 32, nR = 16384L * 128;
  for (long it = (long)blockIdx.x * NT + tid; it < nM + nR; it += (long)gridDim.x * NT) {
    int pos, i; double frac;
    if (it < nM) { pos = (int)(it >> 5); i = (int)(it & 31); frac = (double)(2 * i) / 64.0; }
    else { const long k = it - nM; pos = (int)(k >> 7); i = (int)(k & 127); frac = (double)(2 * i) / 256.0; }
    const float inv = (float)exp(-frac * 9.210340371976184);
    const float ang = (float)pos * inv;
    const double a = (double)ang;
    const double kk = rint(a * 0.15915494309189535);
    const double rr = fma(-kk, 6.283185307179586, a);
    float s, c;
    sincos_d(rr, s, c);
    if (it < nM) tabM[it] = make_float2(c, s); else tabR[it - nM] = make_float2(c, s);
  }
}

constexpr int ATT_VLD = 68;
constexpr int ATT_KSLOT = 64 * 200, ATT_VSLOT = 128 * ATT_VLD, ATT_VBASE = 2 * ATT_KSLOT;
DI void attn_pv(f32x16 (&oT)[4], const bf16* Vs, const bf16x8 (&pb)[4], int r, int h) {
#pragma unroll
  for (int d0 = 0; d0 < 4; ++d0) {
    const bf16* vb = Vs + (32 * d0 + r) * ATT_VLD + 4 * h;
#pragma unroll
    for (int s = 0; s < 4; ++s) {
      const int kbase = (s >> 1) * 32 + (s & 1) * 16;
      const s16x4 lo = *(const s16x4*)(vb + kbase), hi = *(const s16x4*)(vb + kbase + 8);
      const bf16x8 va = __builtin_shufflevector(lo, hi, 0, 1, 2, 3, 4, 5, 6, 7);
      oT[d0] = MFMA(va, pb[s], oT[d0]);
    }
  }
}
DI void attn_tile(const bf16* Q, const bf16* Kn, const bf16* Kp, const bf16* Vt, bf16* O, int S, bf16* lds) {
  int tid = threadIdx.x;
  asm volatile("" : "+v"(tid));
  const int lane = tid & 63, wid = tid >> 6, r = lane & 31, h = lane >> 5;
  const bool late = wid >= 4;
  constexpr float C = 0.07216878364870322f * 1.4426950408889634f;
  bf16x8 qr[12];
  {
    const bf16* qp = Q + (long)(wid * 32 + r) * 1536 + h * 8;
#pragma unroll
    for (int d0 = 0; d0 < 12; ++d0) qr[d0] = *(const bf16x8*)(qp + d0 * 16);
  }
  f32x16 oT[4];
#pragma unroll
  for (int d0 = 0; d0 < 4; ++d0)
#pragma unroll
    for (int i = 0; i < 16; ++i) oT[d0][i] = 0.f;
  float m = -1e30f, l = 0.f;
  u32x4 skA[2], spA, svA[2], skB[2], spB, svB[2];
  const unsigned okn = (unsigned)(((tid >> 4) * 1024 + (tid & 15) * 8) * 2);
  const unsigned okp = (unsigned)(((tid >> 3) * 64 + (tid & 7) * 8) * 2);
  const unsigned ovt = (unsigned)(((tid >> 3) * 64 + (tid & 7) * 8) * 2);
  const int sko = (tid >> 4) * 200 + (tid & 15) * 8, spo = (tid >> 3) * 200 + 128 + (tid & 7) * 8, svo = (tid >> 3) * ATT_VLD + (tid & 7) * 8;
#define ATT_LOAD(X, key0) do { \
    const char* kn_ = (const char*)(Kn + (long)(key0) * 1024); const char* kp_ = (const char*)(Kp + (long)(key0) * 64); const char* vt_ = (const char*)(Vt + (long)(key0) * 128); \
    sk##X[0] = *(const u32x4*)(kn_ + okn); sk##X[1] = *(const u32x4*)(kn_ + (size_t)32 * 2048 + okn); \
    sp##X = *(const u32x4*)(kp_ + okp); \
    sv##X[0] = *(const u32x4*)(vt_ + ovt); sv##X[1] = *(const u32x4*)(vt_ + (size_t)64 * 64 * 2 + ovt); } while (0)
#define ATT_STORE(X, kslot, vslot) do { bf16* k_ = lds + (kslot) * ATT_KSLOT; bf16* v_ = lds + ATT_VBASE + (vslot) * ATT_VSLOT; \
    *(u32x4*)(k_ + sko) = sk##X[0]; *(u32x4*)(k_ + sko + 32 * 200) = sk##X[1]; *(u32x4*)(k_ + spo) = sp##X; \
    *(u32x2*)(v_ + svo) = (u32x2){sv##X[0][0], sv##X[0][1]}; *(u32x2*)(v_ + svo + 4) = (u32x2){sv##X[0][2], sv##X[0][3]}; \
    *(u32x2*)(v_ + svo + 64 * ATT_VLD) = (u32x2){sv##X[1][0], sv##X[1][1]}; *(u32x2*)(v_ + svo + 64 * ATT_VLD + 4) = (u32x2){sv##X[1][2], sv##X[1][3]}; } while (0)
  const int nt = S >> 6;
  __syncthreads();
  ATT_LOAD(A, 0);
  ATT_STORE(A, 0, 0);
  if (nt > 1) ATT_LOAD(B, 64);
  __syncthreads();
  bf16x8 pb[4];
#pragma unroll
  for (int i = 0; i < 4; ++i)
#pragma unroll
    for (int k = 0; k < 8; ++k) pb[i][k] = 0;
  int vs_cur = 0;
  int vs_prev = 2;
  for (int j = 0; j < nt; ++j) {
    {
    const bool more = (j + 1 < nt);
    const bool more2 = (j + 2 < nt);
    const bf16* Ks = lds + (j & 1) * ATT_KSLOT;
    if (more2) ATT_LOAD(A, (j + 2) * 64);
    if (late && j > 0) attn_pv(oT, lds + ATT_VBASE + vs_prev * ATT_VSLOT, pb, r, h);
    f32x16 p0, p1;
#pragma unroll
    for (int i = 0; i < 16; ++i) { p0[i] = 0.f; p1[i] = 0.f; }
    const bf16* kb = Ks + r * 200 + h * 8;
#pragma unroll
    for (int d0 = 0; d0 < 12; ++d0) {
      const bf16x8 ka0 = *(const bf16x8*)(kb + d0 * 16), ka1 = *(const bf16x8*)(kb + 32 * 200 + d0 * 16);
      p0 = MFMA(ka0, qr[d0], p0);
      p1 = MFMA(ka1, qr[d0], p1);
    }
    float mx = p0[0];
#pragma unroll
    for (int i = 1; i < 16; ++i) mx = fmaxf(mx, p0[i]);
#pragma unroll
    for (int i = 0; i < 16; ++i) mx = fmaxf(mx, p1[i]);
    mx = half_max(mx);
    if (__any((mx - m) * C > 11.5f)) {
      const float mn = fmaxf(m, mx);
      const float alpha = __builtin_amdgcn_exp2f((m - mn) * C);
      m = mn;
      l *= alpha;
#pragma unroll
      for (int d0 = 0; d0 < 4; ++d0)
#pragma unroll
        for (int i = 0; i < 16; ++i) oT[d0][i] *= alpha;
    }
    const float mc = m * C;
    float ps = 0.f;
#pragma unroll
    for (int i = 0; i < 16; ++i) { p0[i] = __builtin_amdgcn_exp2f(p0[i] * C - mc); ps += p0[i]; }
#pragma unroll
    for (int i = 0; i < 16; ++i) { p1[i] = __builtin_amdgcn_exp2f(p1[i] * C - mc); ps += p1[i]; }
    ps = half_sum(ps);
    l += ps;
    {
      u32x4 w0 = {pk2(p0[0], p0[1]), pk2(p0[2], p0[3]), pk2(p0[4], p0[5]), pk2(p0[6], p0[7])};
      u32x4 w1 = {pk2(p0[8], p0[9]), pk2(p0[10], p0[11]), pk2(p0[12], p0[13]), pk2(p0[14], p0[15])};
      u32x4 w2 = {pk2(p1[0], p1[1]), pk2(p1[2], p1[3]), pk2(p1[4], p1[5]), pk2(p1[6], p1[7])};
      u32x4 w3 = {pk2(p1[8], p1[9]), pk2(p1[10], p1[11]), pk2(p1[12], p1[13]), pk2(p1[14], p1[15])};
      pb[0] = __builtin_bit_cast(bf16x8, w0); pb[1] = __builtin_bit_cast(bf16x8, w1);
      pb[2] = __builtin_bit_cast(bf16x8, w2); pb[3] = __builtin_bit_cast(bf16x8, w3);
    }
    const int vs_next = (vs_cur == 2) ? 0 : vs_cur + 1;
    if (!late) attn_pv(oT, lds + ATT_VBASE + vs_cur * ATT_VSLOT, pb, r, h);
    if (more) ATT_STORE(B, (j + 1) & 1, vs_next);
    vs_prev = vs_cur; vs_cur = vs_next;
    __syncthreads();
    }
    if (++j >= nt) break;
    {
    const bool more = (j + 1 < nt);
    const bool more2 = (j + 2 < nt);
    const bf16* Ks = lds + (j & 1) * ATT_KSLOT;
    if (more2) ATT_LOAD(B, (j + 2) * 64);
    if (late && j > 0) attn_pv(oT, lds + ATT_VBASE + vs_prev * ATT_VSLOT, pb, r, h);
    f32x16 p0, p1;
#pragma unroll
    for (int i = 0; i < 16; ++i) { p0[i] = 0.f; p1[i] = 0.f; }
    const bf16* kb = Ks + r * 200 + h * 8;
#pragma unroll
    for (int d0 = 0; d0 < 12; ++d0) {
      const bf16x8 ka0 = *(const bf16x8*)(kb + d0 * 16), ka1 = *(const bf16x8*)(kb + 32 * 200 + d0 * 16);
      p0 = MFMA(ka0, qr[d0], p0);
      p1 = MFMA(ka1, qr[d0], p1);
    }
    float mx = p0[0];
#pragma unroll
    for (int i = 1; i < 16; ++i) mx = fmaxf(mx, p0[i]);
#pragma unroll
    for (int i = 0; i < 16; ++i) mx = fmaxf(mx, p1[i]);
    mx = half_max(mx);
    if (__any((mx - m) * C > 11.5f)) {
      const float mn = fmaxf(m, mx);
      const float alpha = __builtin_amdgcn_exp2f((m - mn) * C);
      m = mn;
      l *= alpha;
#pragma unroll
      for (int d0 = 0; d0 < 4; ++d0)
#pragma unroll
        for (int i = 0; i < 16; ++i) oT[d0][i] *= alpha;
    }
    const float mc = m * C;
    float ps = 0.f;
#pragma unroll
    for (int i = 0; i < 16; ++i) { p0[i] = __builtin_amdgcn_exp2f(p0[i] * C - mc); ps += p0[i]; }
#pragma unroll
    for (int i = 0; i < 16; ++i) { p1[i] = __builtin_amdgcn_exp2f(p1[i] * C - mc); ps += p1[i]; }
    ps = half_sum(ps);
    l += ps;
    {
      u32x4 w0 = {pk2(p0[0], p0[1]), pk2(p0[2], p0[3]), pk2(p0[4], p0[5]), pk2(p0[6], p0[7])};
      u32x4 w1 = {pk2(p0[8], p0[9]), pk2(p0[10], p0[11]), pk2(p0[12], p0[13]), pk2(p0[14], p0[15])};
      u32x4 w2 = {pk2(p1[0], p1[1]), pk2(p1[2], p1[3]), pk2(p1[4], p1[5]), pk2(p1[6], p1[7])};
      u32x4 w3 = {pk2(p1[8], p1[9]), pk2(p1[10], p1[11]), pk2(p1[12], p1[13]), pk2(p1[14], p1[15])};
      pb[0] = __builtin_bit_cast(bf16x8, w0); pb[1] = __builtin_bit_cast(bf16x8, w1);
      pb[2] = __builtin_bit_cast(bf16x8, w2); pb[3] = __builtin_bit_cast(bf16x8, w3);
    }
    const int vs_next = (vs_cur == 2) ? 0 : vs_cur + 1;
    if (!late) attn_pv(oT, lds + ATT_VBASE + vs_cur * ATT_VSLOT, pb, r, h);
    if (more) ATT_STORE(A, (j + 1) & 1, vs_next);
    vs_prev = vs_cur; vs_cur = vs_next;
    __syncthreads();
    }
  }
  if (late) attn_pv(oT, lds + ATT_VBASE + vs_prev * ATT_VSLOT, pb, r, h);
#undef ATT_LOAD
#undef ATT_STORE
  const float il = 1.f / l;
  bf16* op = O + (long)(wid * 32 + r) * 1024 + 4 * h;
#pragma unroll
  for (int d0 = 0; d0 < 4; ++d0)
#pragma unroll
    for (int g = 0; g < 4; ++g) {
      u32x2 o = {pk2(oT[d0][4 * g] * il, oT[d0][4 * g + 1] * il), pk2(oT[d0][4 * g + 2] * il, oT[d0][4 * g + 3] * il)};
      *(u32x2*)(op + 32 * d0 + 8 * g) = o;
    }
}

constexpr int ST_LD = 264;
DI void chain_task(const bf16* RQ, const bf16* RKT, const bf16* RVT, bf16* Od, float* stF,
                   int tu0, int nsteps, int head, int dir, int slice, float lg, bf16* lds, int init_from_slot, int state_only) {
  int tid = ltid();
  bf16* STL = lds;
  bf16* W = lds + 128 * ST_LD;
  f32x16 sacc[2][2];
  {
    const int t2 = tid;
    if (init_from_slot) {
      const float* sp_ = stF + t2;
      CH_LOOP {
#pragma unroll
        for (int e = 0; e < 4; ++e) sacc[mi][ni][4 * g + e] = sp_[((mi * 2 + ni) * 16 + 4 * g + e) * NT];
      }
    } else {
      zero_acc(sacc);
    }
  }
  const float cdec = __expf(128.f * lg);
  __syncthreads();
  for (int step = 0; step <= nsteps; ++step) {
    asm volatile("" : "+v"(tid));
    const int lane = tid & 63, wid = tid >> 6, r = lane & 31, h = lane >> 5, wm = wid >> 2, wn = wid & 3;
    const int lrow = tid >> 3, lk = (tid & 7) * 8;
    if (step == nsteps) break;
    if (!state_only) {
      CH_LOOP {
#pragma unroll
        for (int e = 0; e < 4; ++e)
          STL[(wm * 64 + mi * 32 + g * 8 + h * 4 + e) * ST_LD + wn * 64 + ni * 32 + r] = tobf(sacc[mi][ni][4 * g + e]);
      }
    }
    const int c = dir ? (nsteps - 1 - step) : step;
    const int tc = tu0 + c * 128;
    const char* Vb = (const char*)(RVT + ((long)(tc >> 7) * 2048 + head * 512 + slice * 128) * 128);
    const char* Kb = (const char*)(RKT + ((long)(tc >> 7) * 1024 + head * 256) * 128);
    const unsigned o3 = (unsigned)((lrow * 128 + lk) * 2);
    u32x4 rv[2][2], rk[2][4];
#pragma unroll
    for (int st = 0; st < 2; ++st) {
#pragma unroll
      for (int i = 0; i < 2; ++i) rv[st][i] = *(const u32x4*)(Vb + (size_t)(64 * i) * 256 + st * 128 + o3);
#pragma unroll
      for (int i = 0; i < 4; ++i) rk[st][i] = *(const u32x4*)(Kb + (size_t)(64 * i) * 256 + st * 128 + o3);
    }
    if (!state_only) {
      const char* Qb = (const char*)(RQ + (long)tc * 1024 + head * 256);
      const unsigned oq = (unsigned)((lrow * 1024 + lk) * 2);
      u32x4 rq[4][2];
#pragma unroll
      for (int s = 0; s < 4; ++s)
#pragma unroll
        for (int i = 0; i < 2; ++i) rq[s][i] = *(const u32x4*)(Qb + (size_t)s * 128 + (size_t)(64 * i) * 2048 + oq);
#pragma unroll
      for (int s = 0; s < 4; ++s)
#pragma unroll
        for (int i = 0; i < 2; ++i) *(u32x4*)(W + (lrow + 64 * i) * ST_LD + s * 64 + lk) = rq[s][i];
      __syncthreads();
      bf16* ob = Od + (long)(tc + wm * 64 + h * 4) * 2048 + head * 512 + slice * 128 + wn * 32 + r;
      bf16 t[2][16];
#pragma unroll
      for (int mi = 0; mi < 2; ++mi)
#pragma unroll
        for (int k = 0; k < 16; ++k) t[mi][k] = ob[(long)(mi * 32 + (k >> 2) * 8 + (k & 3)) * 2048];
      f32x16 qacc[2];
#pragma unroll
      for (int mi = 0; mi < 2; ++mi)
#pragma unroll
        for (int k = 0; k < 16; ++k) qacc[mi][k] = 0.f;
      {
        const bf16* Ac = W + (wm * 64 + r) * ST_LD + h * 8;
        const bf16* Bc = STL + (wn * 32 + r) * ST_LD + h * 8;
#pragma unroll
        for (int kk = 0; kk < 16; ++kk) {
          const bf16x8 a0 = *(const bf16x8*)(Ac + kk * 16), a1 = *(const bf16x8*)(Ac + 32 * ST_LD + kk * 16);
          const bf16x8 b0 = *(const bf16x8*)(Bc + kk * 16);
          qacc[0] = MFMA(a0, b0, qacc[0]);
          qacc[1] = MFMA(a1, b0, qacc[1]);
        }
      }
#pragma unroll
      for (int mi = 0; mi < 2; ++mi)
#pragma unroll
        for (int k = 0; k < 16; ++k) {
          const int i = wm * 64 + mi * 32 + (k >> 2) * 8 + h * 4 + (k & 3);
          const float qd = __expf(lg * (float)(dir ? (128 - i) : (i + 1)));
          ob[(long)(mi * 32 + (k >> 2) * 8 + (k & 3)) * 2048] = tobf(bf2f(t[mi][k]) + qd * qacc[mi][k]);
        }
      __syncthreads();
    }
#pragma unroll
    for (int mi = 0; mi < 2; ++mi)
#pragma unroll
      for (int ni = 0; ni < 2; ++ni)
#pragma unroll
        for (int k = 0; k < 16; ++k) sacc[mi][ni][k] *= cdec;
#pragma unroll
    for (int st = 0; st < 2; ++st) {
      bf16* As3 = W;
      bf16* Bs3 = W + 128 * LDT;
#pragma unroll
      for (int i = 0; i < 2; ++i) *(u32x4*)(As3 + (lrow + 64 * i) * LDT + lk) = rv[st][i];
#pragma unroll
      for (int i = 0; i < 4; ++i) *(u32x4*)(Bs3 + (lrow + 64 * i) * LDT + lk) = rk[st][i];
      __syncthreads();
      const bf16* Ac = As3 + (wm * 64 + r) * LDT + h * 8;
      const bf16* Bc = Bs3 + (wn * 64 + r) * LDT + h * 8;
#pragma unroll
      for (int ks = 0; ks < 4; ++ks) {
        const bf16x8 a0 = *(const bf16x8*)(Ac + ks * 16), a1 = *(const bf16x8*)(Ac + 32 * LDT + ks * 16);
        const bf16x8 b0 = *(const bf16x8*)(Bc + ks * 16), b1 = *(const bf16x8*)(Bc + 32 * LDT + ks * 16);
        sacc[0][0] = MFMA(a0, b0, sacc[0][0]); sacc[0][1] = MFMA(a0, b1, sacc[0][1]);
        sacc[1][0] = MFMA(a1, b0, sacc[1][0]); sacc[1][1] = MFMA(a1, b1, sacc[1][1]);
      }
      __syncthreads();
    }
  }
  if (state_only) {
    float* sp_ = stF + tid;
    CH_LOOP {
#pragma unroll
      for (int e = 0; e < 4; ++e) sp_[((mi * 2 + ni) * 16 + 4 * g + e) * NT] = sacc[mi][ni][4 * g + e];
    }
  }
  __syncthreads();
}

DI void ret_intra_item(const bf16* RQ, const bf16* RK, const bf16* RVT, bf16* Od, bf16* att, int tc, int head, int dir, float lg, bf16* lds) {
  int tid = ltid();
  const int lane = tid & 63, wid = tid >> 6, r = lane & 31, h = lane >> 5, wm = wid >> 2, wn = wid & 3;
  const bf16* Qc = RQ + (long)tc * 1024 + head * 256;
  const bf16* Kc = RK + (long)tc * 1024 + head * 256;
  f32x16 acc[2][2];
  zero_acc(acc);
  gemm128_mainloop<2>(acc, Qc, 1024, Kc, 1024, Kc, 1024, 256, lds, tid, 0);
  if (wn < 2) {
    CH_LOOP {
#pragma unroll
      for (int e = 0; e < 4; ++e) {
        const int i = wm * 64 + mi * 32 + g * 8 + h * 4 + e, jx = wn * 64 + ni * 32 + r;
        const int diff = dir ? (jx - i) : (i - jx);
        const float v = diff >= 0 ? acc[mi][ni][4 * g + e] * __expf(lg * (float)diff) : 0.f;
        att[i * 128 + jx] = tobf(v);
      }
    }
  }
  __syncthreads();
#pragma unroll 1
  for (int vh = 0; vh < 2; ++vh) {
    const bf16* Vc = RVT + ((long)(tc >> 7) * 2048 + head * 512 + vh * 256) * 128;
    zero_acc(acc);
    gemm128_mainloop<4>(acc, att, 128, Vc, 128, Vc + 128 * 128, 128, 128, lds, tid, 0);
    CH_LOOP {
#pragma unroll
      for (int e = 0; e < 4; ++e) {
        const int i = wm * 64 + mi * 32 + g * 8 + h * 4 + e;
        Od[(long)(tc + i) * 2048 + head * 512 + vh * 256 + wn * 64 + ni * 32 + r] = tobf(acc[mi][ni][4 * g + e]);
      }
    }
  }
  __syncthreads();
}

DI void phase_chain_combine(char* SCR, const float* lgf_raw, const float* lgb_raw) {
  const int tid = ltid();
  const long total = 32L * 32768;
  for (long it = (long)blockIdx.x * NT + tid; it < total; it += (long)gridDim.x * NT) {
    const int hds = (int)(it >> 15), e = (int)(it & 32767);
    const int slice = hds & 3, dir = (hds >> 2) & 1, head = hds >> 3;
    const float lg = neg_softplus(dir ? lgb_raw[head] : lgf_raw[head]);
    const float cseg = __expf(2048.f * lg);
    const int k = e >> 9, t = e & 511;
    const int mi = k >> 5, ni = (k >> 4) & 1, g = (k >> 2) & 3, ee = k & 3;
    const int wid = t >> 6, hh = (t >> 5) & 1, r = t & 31;
    const int v = (wid >> 2) * 64 + mi * 32 + g * 8 + hh * 4 + ee, d = (wid & 3) * 64 + ni * 32 + r;
    float en[8];
#pragma unroll
    for (int s = 0; s < 8; ++s) {
      const int u = dir ? (7 - s) : s;
      const char* slot = SCR + (long)((((u * 4 + head) * 2 + dir) * 4) + slice) * 163840;
      en[s] = (s < 7) ? ((const float*)(slot + 32768))[e] : 0.f;
    }
    float prev = 0.f;
#pragma unroll
    for (int s = 0; s < 8; ++s) {
      const int u = dir ? (7 - s) : s;
      char* slot = SCR + (long)((((u * 4 + head) * 2 + dir) * 4) + slice) * 163840;
      ((float*)(slot + 32768))[e] = prev;
      prev = cseg * prev + en[s];
    }
  }
}

__global__ void __launch_bounds__(512, 2) mega(Params p) {
  __shared__ __attribute__((aligned(16))) char smem[SMEM_BYTES];
  cg::grid_group grid = cg::this_grid();
  bf16* lds = (bf16*)smem;
  KP pp = kargs();
  char* ws = pp->ws;
  const bf16* WB = (const bf16*)ws;
  const float2* tabM = (const float2*)(ws + OFF_TABM);
  const float2* tabR = (const float2*)(ws + OFF_TABR);
  const int nb = gridDim.x, bid = blockIdx.x;

  unsigned bar_gen = 0;
  if (blockIdx.x == 0) {
    const int t0 = ltid();
    if (t0 < 33) __hip_atomic_store((unsigned*)(ws + OFF_BAR) + 64 * t0, 0u, __ATOMIC_RELAXED, __HIP_MEMORY_SCOPE_AGENT);
  }
  phase_prologue(pp, (float*)smem);
  grid.sync();

  for (int L = 0; L < 4; ++L) {
    const int kind = L % 3, jl = L / 3;
    if (kind == 0) {
#define MLA_CTX \
        KP pp = kargs(); char* SB = pp->ws + OFF_S; \
        const bf16* WA = (const bf16*)pp->ws + jl * MLA_SZ; const bf16* WUQ = WA + MLA_WUQ; const bf16* WUKV = WA + MLA_WUKV; const bf16* WO = WA + MLA_WO; \
        const float2* tabM = (const float2*)(pp->ws + OFF_TABM); \
        const int S = hf ? 16384 : 2048; \
        const float* xin = (L == 0) ? pp->in[hf] : (pp->out + (long)hf * TH * 1024); \
        float* xout = pp->out + (long)hf * TH * 1024; \
        bf16* H = (bf16*)SB; bf16* CA = (bf16*)(SB + 64 * MiB); bf16* KPE = (bf16*)(SB + 104 * MiB); bf16* Q = (bf16*)(SB + 108 * MiB); \
        bf16* KN = (bf16*)(SB + 204 * MiB); bf16* VT = (bf16*)(SB + 268 * MiB); \
        (void)WA; (void)WUQ; (void)WUKV; (void)WO; (void)tabM; (void)S; (void)xin; (void)xout; (void)H; (void)CA; (void)KPE; (void)Q; (void)KN; (void)VT;
      for (int hf = 0; hf < 2; ++hf) {
        { MLA_CTX phase_rmsnorm_bf16(xin, pp->in[2] + L * 1024, H, TH); }
        gsync(bar_gen);
        { MLA_CTX
        gemm_phase(H, 1024, WA, 1024, 1024, 16 * 3, nb, lds, MAP_STD(3, 1024, 1024),
            [&](f32x16 (&acc)[4][2], int mw, int nw, int r, int h) {
              if (nw < 640) {
                EPI_LOOP {
#pragma unroll
                  for (int e = 0; e < 4; ++e) CA[(long)(mw + mi * 32 + g * 8 + h * 4 + e) * 640 + nw + ni * 32 + r] = tobf(acc[mi][ni][4 * g + e]);
                }
              } else if (nw == 640) {
                EPI_LOOP_PAIR {
#pragma unroll
                  for (int e = 0; e < 4; ++e) {
                    const int t = mw + mi * 32 + g * 8 + h * 4 + e;
                    const float2 cs = tabM[(long)(t & (S - 1)) * 32 + r];
                    const float a = acc[mi][0][4 * g + e], b = acc[mi][1][4 * g + e];
                    KPE[(long)t * 64 + r] = tobf(a * cs.x - b * cs.y);
                    KPE[(long)t * 64 + 32 + r] = tobf(a * cs.y + b * cs.x);
                  }
                }
              }
            });
        }
        gsync(bar_gen);
        { MLA_CTX phase_mla_rownorm(CA, pp->in[5] + jl * 384, pp->in[8] + jl * 256, TH); }
        gsync(bar_gen);
        { MLA_CTX
        gemm_phase(CA, 640, WUQ, 384, 384, 16 * 6, nb, lds, MAP_STD(6, 640, 384),
              [&](f32x16 (&acc)[4][2], int mw, int nw, int r, int h) {
                if ((nw % 192) != 128) {
                  EPI_LOOP {
#pragma unroll
                    for (int e = 0; e < 4; ++e) Q[(long)(mw + mi * 32 + g * 8 + h * 4 + e) * 1536 + nw + ni * 32 + r] = tobf(acc[mi][ni][4 * g + e]);
                  }
                } else {
                  EPI_LOOP_PAIR {
#pragma unroll
                    for (int e = 0; e < 4; ++e) {
                      const int t = mw + mi * 32 + g * 8 + h * 4 + e;
                      const float2 cs = tabM[(long)(t & (S - 1)) * 32 + r];
                      const float a = acc[mi][0][4 * g + e], b = acc[mi][1][4 * g + e];
                      Q[(long)t * 1536 + nw + r] = tobf(a * cs.x - b * cs.y);
                      Q[(long)t * 1536 + nw + 32 + r] = tobf(a * cs.y + b * cs.x);
                    }
                  }
                }
              });
        gemm_phase(CA + 384, 640, WUKV, 256, 256, 16 * 8, nb, lds, MAP_STD(8, 640, 256),
              [&](f32x16 (&acc)[4][2], int mw, int nw, int r, int h) {
                const int head = nw >> 8, w = nw & 255;
                if (w < 128) {
                  EPI_LOOP {
#pragma unroll
                    for (int e = 0; e < 4; ++e) KN[(long)(mw + mi * 32 + g * 8 + h * 4 + e) * 1024 + head * 128 + w + ni * 32 + r] = tobf(acc[mi][ni][4 * g + e]);
                  }
                } else {
                  EPI_LOOP {
                    const int t = mw + mi * 32 + g * 8 + h * 4;
                    const int b = t / S, s = t & (S - 1);
                    const int d = (w - 128) + ni * 32 + r;
                    u32x2 o = {pk2(acc[mi][ni][4 * g], acc[mi][ni][4 * g + 1]), pk2(acc[mi][ni][4 * g + 2], acc[mi][ni][4 * g + 3])};
                    *(u32x2*)(VT + (long)(b * 8 + head) * 128 * S + (long)(s >> 6) * 8192 + d * 64 + (s & 63)) = o;
                  }
                }
              });
        }
        gsync(bar_gen);
        { MLA_CTX
          const int nqb = S >> 8;
          for (int q_ = lbid() >> 3; q_ < 128; q_ += (nb >> 3)) {
            const int qb = q_ % nqb, bh = (int)(blockIdx.x & 7) + 8 * (q_ / nqb), head = bh & 7, b = bh >> 3;
            attn_tile(Q + (long)(b * S + qb * 256) * 1536 + head * 192, KN + (long)(b * S) * 1024 + head * 128, KPE + (long)(b * S) * 64,
                      VT + (long)((b * 8 + head) * 128) * S, H + (long)(b * S + qb * 256) * 1024 + head * 128, S, lds);
          }
        }
        gsync(bar_gen);
        { MLA_CTX
        gemm_phase<true>(H, 1024, WO, 1024, 1024, 16 * 4, nb, lds, MAP_STD(4, 1024, 1024),
            [&](f32x16 (&acc)[4][2], int mw, int nw, int r, int h) {
              epi_residual(acc, xin, xout, nullptr, mw, nw, r, h);
            });
        }
        gsync(bar_gen);
      }
#undef MLA_CTX
    } else if (kind == 1) {
      const bf16* WQKV = WB + WB_RET;
      const bf16* WG = WQKV + RET_WG;
      const bf16* WOr = WQKV + RET_WO;
      for (int qt = 0; qt < 4; ++qt) {
        KP pp = kargs(); char* SB = pp->ws + OFF_S;
        const int S = qt < 2 ? 2048 : 16384;
        float* x = pp->out + (long)qt * TQ * 1024;
        bf16* Hh = (bf16*)SB;
        char* SCR = SB + 32 * MiB;
        bf16* RQ = (bf16*)(SB + 72 * MiB);
        bf16* RK = (bf16*)(SB + 104 * MiB);
        bf16* RKTF = (bf16*)(SB + 136 * MiB);
        bf16* RKTB = (bf16*)(SB + 168 * MiB);
        bf16* RVT = (bf16*)(SB + 200 * MiB);
        bf16* OF = (bf16*)(SB + 264 * MiB);
        bf16* OB = (bf16*)(SB + 328 * MiB);
        phase_rmsnorm_bf16(x, pp->in[2] + L * 1024, Hh, TQ);
        gsync(bar_gen);
        gemm_phase(Hh, 1024, WQKV, 1024, 1024, 8 * 16, nb, lds, MAP_2D(16, 1024, 1024),
            [&](f32x16 (&acc)[4][2], int mw, int nw, int r, int h) {
              if (nw < 2048) {
                const int isk = nw >= 1024, n2 = nw & 1023, head = n2 >> 8, blk = (n2 & 255) >> 6;
                const float lgf = neg_softplus(pp->in[16][jl * 4 + head]), lgb = neg_softplus(pp->in[17][jl * 4 + head]);
                const int d1 = head * 256 + blk * 32 + r, d2 = d1 + 128;
                EPI_LOOP_PAIR {
                  const int t0 = mw + mi * 32 + g * 8 + h * 4;
                  float o1[4], o2[4];
#pragma unroll
                  for (int e = 0; e < 4; ++e) {
                    const float2 cs = tabR[(long)((t0 + e) & (S - 1)) * 128 + blk * 32 + r];
                    const float a = acc[mi][0][4 * g + e], b = acc[mi][1][4 * g + e];
                    o1[e] = a * cs.x - b * cs.y; o2[e] = a * cs.y + b * cs.x;
                  }
                  if (!isk) {
#pragma unroll
                    for (int e = 0; e < 4; ++e) { RQ[(long)(t0 + e) * 1024 + d1] = tobf(o1[e]); RQ[(long)(t0 + e) * 1024 + d2] = tobf(o2[e]); }
                  } else {
                    float f1[4], f2[4], b1[4], b2[4];
#pragma unroll
                    for (int e = 0; e < 4; ++e) {
                      o1[e] *= 0.0625f; o2[e] *= 0.0625f;
                      RK[(long)(t0 + e) * 1024 + d1] = tobf(o1[e]); RK[(long)(t0 + e) * 1024 + d2] = tobf(o2[e]);
                      const int jj = (t0 + e) & 127;
                      const float df = __expf(lgf * (float)(127 - jj)), db = __expf(lgb * (float)jj);
                      f1[e] = o1[e] * df; f2[e] = o2[e] * df; b1[e] = o1[e] * db; b2[e] = o2[e] * db;
                    }
                    u32x2 v;
                    v = (u32x2){pk2(f1[0], f1[1]), pk2(f1[2], f1[3])}; *(u32x2*)(RKTF + ((long)(t0 >> 7) * 1024 + d1) * 128 + (t0 & 127)) = v;
                    v = (u32x2){pk2(f2[0], f2[1]), pk2(f2[2], f2[3])}; *(u32x2*)(RKTF + ((long)(t0 >> 7) * 1024 + d2) * 128 + (t0 & 127)) = v;
                    v = (u32x2){pk2(b1[0], b1[1]), pk2(b1[2], b1[3])}; *(u32x2*)(RKTB + ((long)(t0 >> 7) * 1024 + d1) * 128 + (t0 & 127)) = v;
                    v = (u32x2){pk2(b2[0], b2[1]), pk2(b2[2], b2[3])}; *(u32x2*)(RKTB + ((long)(t0 >> 7) * 1024 + d2) * 128 + (t0 & 127)) = v;
                  }
                }
              } else {
                EPI_LOOP {
                  const int t0 = mw + mi * 32 + g * 8 + h * 4;
                  const int c = nw - 2048 + ni * 32 + r;
                  u32x2 o = {pk2(acc[mi][ni][4 * g], acc[mi][ni][4 * g + 1]), pk2(acc[mi][ni][4 * g + 2], acc[mi][ni][4 * g + 3])};
                  *(u32x2*)(RVT + ((long)(t0 >> 7) * 2048 + c) * 128 + (t0 & 127)) = o;
                }
              }
            });
        gsync(bar_gen);
        {
          for (int item = lbid(); item < 1024; item += nb) {
            const int dir = item & 1, head = (item >> 1) & 3, ck = item >> 3;
            const float lg = neg_softplus(pp->in[dir ? 17 : 16][jl * 4 + head]);
            ret_intra_item(RQ, RK, RVT, dir ? OB : OF, (bf16*)(SCR + (long)blockIdx.x * 163840), ck * 128, head, dir, lg, lds);
          }
          if (qt < 2) gsync(bar_gen);
          for (int pass = (qt >= 2 ? 0 : 1); pass < 2; ++pass) {
            for (int task = lbid(); task < 256; task += nb) {
              const int slice = task & 3, dir = (task >> 2) & 1, head = (task >> 3) & 3, u = task >> 5;
              if (pass == 0 && ((dir == 0 && u == 7) || (dir == 1 && u == 0))) continue;
              const float lg = neg_softplus(pp->in[dir ? 17 : 16][jl * 4 + head]);
              chain_task(RQ, dir ? RKTB : RKTF, RVT, dir ? OB : OF, (float*)(SCR + (long)task * 163840 + 32768), u * 2048, 16, head, dir, slice, lg, lds,
                         (pass == 1 && qt >= 2) ? 1 : 0, pass == 0 ? 1 : 0);
            }
            if (pass == 0) {
              gsync(bar_gen);
              phase_chain_combine(SCR, pp->in[16] + jl * 4, pp->in[17] + jl * 4);
              gsync(bar_gen);
            }
          }
        }
        gsync(bar_gen);
        phase_onorm(OF, OB, TQ);
        gsync(bar_gen);
        gemm_phase<true>(Hh, 1024, WG, 1024, 1024, 8 * 8, nb, lds, MAP_2D(8, 1024, 1024),
            [&](f32x16 (&acc)[4][2], int mw, int nw, int r, int h) {
#pragma unroll
              for (int mi = 0; mi < 4; ++mi) {
                unsigned t[16];
#pragma unroll
                for (int k = 0; k < 16; ++k) t[k] = *(const unsigned*)(OF + (long)(mw + mi * 32 + (k >> 2) * 8 + h * 4 + (k & 3)) * 2048 + nw + 2 * r);
#pragma unroll
                for (int k = 0; k < 16; ++k) {
                  const float g0 = acc[mi][0][k], g1 = acc[mi][1][k];
                  const float s0 = g0 / (1.f + __expf(-g0)), s1 = g1 / (1.f + __expf(-g1));
                  *(unsigned*)(OF + (long)(mw + mi * 32 + (k >> 2) * 8 + h * 4 + (k & 3)) * 2048 + nw + 2 * r) =
                      pk2(s0 * __uint_as_float(t[k] << 16), s1 * __uint_as_float(t[k] & 0xffff0000u));
                }
              }
            });
        gsync(bar_gen);
        gemm_phase<true>(OF, 2048, WOr, 2048, 2048, 8 * 4, nb, lds, MAP_STD(4, 2048, 2048),
            [&](f32x16 (&acc)[4][2], int mw, int nw, int r, int h) {
              epi_residual(acc, x, x, nullptr, mw, nw, r, h);
            });
        gsync(bar_gen);
      }
    } else {
      const bf16* WP = WB + WB_POOL;
      const float* psc = pp->in[19] + jl * 1024;
      for (int hf = 0; hf < 2; ++hf) {
        KP pp = kargs(); char* SB = pp->ws + OFF_S;
        const int S = hf ? 16384 : 2048;
        float* x = pp->out + (long)hf * TH * 1024;
        bf16* H = (bf16*)SB;
        bf16* PL = (bf16*)(SB + 64 * MiB);
        phase_rmsnorm_bf16(x, pp->in[2] + L * 1024, H, TH);
        gsync(bar_gen);
        phase_pool(H, PL, TH, S);
        gsync(bar_gen);
        gemm_phase<true>(PL, 1024, WP, 256, 256, 16 * 4, nb, lds,
            [&](int q_, long& ao, long& bo, int& mr, int& nc) { const int gq = TILE_TN(4); mr = TILE_TM(4) * 256; nc = gq * 256; ao = (long)mr * 1024 + gq * 256; bo = (long)gq * 65536; },
            [&](f32x16 (&acc)[4][2], int mw, int nw, int r, int h) {
              epi_residual(acc, x, x, psc, mw, nw, r, h);
            });
        gsync(bar_gen);
      }
    }
    {
      const bf16* W1 = WB + WB_MLP + (long)L * MLP_SZ;
      const bf16* W2 = W1 + MLP_W2;
      for (int hf = 0; hf < 2; ++hf) {
        KP pp = kargs(); char* SB = pp->ws + OFF_S;
        float* x = pp->out + (long)hf * TH * 1024;
        bf16* H = (bf16*)SB;
        bf16* HID = (bf16*)(SB + 64 * MiB);
        if (hf == 0) {
          phase_rmsnorm_bf16(x, pp->in[3] + L * 1024, H, TH);
          gsync(bar_gen);
        }
        gemm_phase<true>(H, 1024, W1, 1024, 1024, 16 * 16, nb, lds, MAP_2D(16, 1024, 1024),
            [&](f32x16 (&acc)[4][2], int mw, int nw, int r, int h) {
#pragma unroll
              for (int mi = 0; mi < 4; ++mi)
#pragma unroll
                for (int k = 0; k < 16; ++k) {
                  const float v0 = fmaxf(acc[mi][0][k], 0.f), v1 = fmaxf(acc[mi][1][k], 0.f);
                  *(unsigned*)(HID + (long)(mw + mi * 32 + (k >> 2) * 8 + h * 4 + (k & 3)) * 4096 + nw + 2 * r) = pk2(v0 * v0, v1 * v1);
                }
            });
        gsync(bar_gen);
        gemm_phase<true>(HID, 4096, W2, 4096, 4096, 16 * 4, nb, lds, MAP_STD(4, 4096, 4096),
            [&](f32x16 (&acc)[4][2], int mw, int nw, int r, int h) {
              epi_residual(acc, x, x, nullptr, mw, nw, r, h);
            });
        if (hf == 0) phase_rmsnorm_bf16(pp->out + (long)TH * 1024, pp->in[3] + L * 1024, H, TH);
        gsync(bar_gen);
      }
    }
  }
  phase_final_norm(pp->out, pp->in[22], T);
}

extern "C" void kernel_launch(void* const* d_in, const int* in_sizes, int n_in, void* d_out, int out_size, void* d_ws, size_t ws_size, hipStream_t stream) {
  static int grid_blocks = 0;
  if (!grid_blocks) {
    int dev = 0, cus = 0, per_cu = 0;
    hipGetDevice(&dev);
    hipDeviceGetAttribute(&cus, hipDeviceAttributeMultiprocessorCount, dev);
    hipOccupancyMaxActiveBlocksPerMultiprocessor(&per_cu, mega, NT, 0);
    if (per_cu > 1) per_cu = 1;
    grid_blocks = (cus * per_cu) & ~15;
    if (grid_blocks > 256) grid_blocks = 256;
    if (grid_blocks <= 0) { fprintf(stderr, "occupancy query failed\n"); grid_blocks = 256; }
  }
  Params p;
  memset(&p, 0, sizeof(p));
  for (int i = 0; i < 23 && i < n_in; ++i) p.in[i] = (const float*)d_in[i];
  p.out = (float*)d_out;
  p.ws = (char*)d_ws;
  int nj = 0;
  auto add = [&](const float* src, long long dst, int K, int N, int perm) { p.jobs[nj].src = src; p.jobs[nj].dst = dst; p.jobs[nj].K = K; p.jobs[nj].N = N; p.jobs[nj].perm = perm; p.jobs[nj].pad = 0; ++nj; };
  for (int j = 0; j < 2; ++j) {
    const long long base = j * MLA_SZ;
    add(p.in[4] + (long)j * 1024 * 384, base, 1024, 384, 0);
    add(p.in[7] + (long)j * 1024 * 320, base + 384L * 1024, 1024, 320, 0);
    add(p.in[6] + (long)j * 384 * 1536, base + MLA_WUQ, 384, 1536, 0);
    add(p.in[9] + (long)j * 256 * 2048, base + MLA_WUKV, 256, 2048, 0);
    add(p.in[10] + (long)j * 1024 * 1024, base + MLA_WO, 1024, 1024, 0);
  }
  add(p.in[11], WB_RET, 1024, 1024, 1);
  add(p.in[12], WB_RET + 1024L * 1024, 1024, 1024, 1);
  add(p.in[13], WB_RET + 2048L * 1024, 1024, 2048, 0);
  add(p.in[14], WB_RET + RET_WG, 1024, 2048, 0);
  add(p.in[15], WB_RET + RET_WO, 2048, 1024, 0);
  for (int g = 0; g < 4; ++g) add(p.in[18] + (long)g * 65536, WB_POOL + (long)g * 65536, 256, 256, 0);
  for (int i = 0; i < 4; ++i) {
    add(p.in[20] + (long)i * 1024 * 4096, WB_MLP + (long)i * MLP_SZ, 1024, 4096, 0);
    add(p.in[21] + (long)i * 4096 * 1024, WB_MLP + (long)i * MLP_SZ + MLP_W2, 4096, 1024, 0);
  }
  p.njobs = nj;
  void* args[] = {&p};
  hipError_t e = hipLaunchCooperativeKernel((void*)mega, dim3(grid_blocks), dim3(NT), args, 0, stream);
  if (e != hipSuccess) fprintf(stderr, "cooperative launch failed: %s (grid %d)\n", hipGetErrorString(e), grid_blocks);
}
```

```cpp
#include <hip/hip_runtime.h>
#include <hip/hip_cooperative_groups.h>
#include <cstdio>
#include <cstdint>
#include <cstring>
namespace cg = cooperative_groups;

typedef unsigned short bf16;
using bf16x8 = __attribute__((ext_vector_type(8))) short;
using s16x4  = __attribute__((ext_vector_type(4))) short;
using f32x16 = __attribute__((ext_vector_type(16))) float;
using f32x4  = __attribute__((ext_vector_type(4))) float;
using u32x4  = __attribute__((ext_vector_type(4))) unsigned;
using u32x2  = __attribute__((ext_vector_type(2))) unsigned;
typedef __bf16 bf2_t __attribute__((ext_vector_type(2)));
typedef float f2_t __attribute__((ext_vector_type(2)));
#define DI __device__ __forceinline__
#define MFMA(a, b, c) __builtin_amdgcn_mfma_f32_32x32x16_bf16((a), (b), (c), 0, 0, 0)

constexpr int T = 65536, TH = 32768, TQ = 16384;
constexpr size_t MiB = (size_t)1 << 20;
constexpr long MLA_WUQ = 768L * 1024, MLA_WUKV = MLA_WUQ + 1536L * 384, MLA_WO = MLA_WUKV + 2048L * 256, MLA_SZ = MLA_WO + 1024L * 1024;
constexpr long WB_RET = 2 * MLA_SZ, RET_WG = 4096L * 1024, RET_WO = RET_WG + 2048L * 1024, RET_SZ = RET_WO + 1024L * 2048;
constexpr long WB_POOL = WB_RET + RET_SZ, POOL_SZ = 4L * 256 * 256;
constexpr long WB_MLP = WB_POOL + POOL_SZ, MLP_W2 = 4096L * 1024, MLP_SZ = 2 * MLP_W2;
constexpr size_t OFF_TABM = 97 * MiB, OFF_TABR = 101 * MiB, OFF_S = 117 * MiB;
constexpr int LDT = 72;
constexpr int NT = 512;
constexpr int SMEM_BYTES = 4 * 256 * LDT * 2;

struct Job { const float* src; long long dst; int K, N, perm, pad; };
struct Params {
  const float* in[23];
  float* out;
  char* ws;
  Job jobs[27];
  int njobs;
  int pad;
};

DI unsigned pk2(float lo, float hi) { f2_t v = {lo, hi}; return __builtin_bit_cast(unsigned, __builtin_convertvector(v, bf2_t)); }
DI bf16 tobf(float x) { return (bf16)(pk2(x, 0.f) & 0xffffu); }
DI float bf2f(bf16 b) { return __uint_as_float(((unsigned)b) << 16); }
typedef const Params __attribute__((address_space(4)))* KP;
DI KP kargs() { KP k = (KP)__builtin_amdgcn_kernarg_segment_ptr(); asm volatile("" : "+s"(k)); return k; }
DI int lbid() { int b = blockIdx.x; asm volatile("" : "+s"(b)); return b; }
DI int ltid() { int t = threadIdx.x; asm volatile("" : "+v"(t)); return t; }
constexpr size_t OFF_BAR = 96 * MiB;
DI void gsync(unsigned& gen) {
  __syncthreads();
  const int t = ltid();
  if (t == 0) {
    KP k = kargs();
    unsigned* bar = (unsigned*)(k->ws + OFF_BAR);
    __builtin_amdgcn_fence(__ATOMIC_RELEASE, "agent");
    asm volatile("s_waitcnt vmcnt(0)" ::: "memory");
    gen += 1;
    const unsigned grp = blockIdx.x & 15u, gsize = (gridDim.x - grp + 15u) >> 4;
    if (__hip_atomic_fetch_add(bar + 64 * (1 + grp), 1u, __ATOMIC_RELAXED, __HIP_MEMORY_SCOPE_AGENT) + 1 == gen * gsize) {
      if (__hip_atomic_fetch_add(bar, 1u, __ATOMIC_RELAXED, __HIP_MEMORY_SCOPE_AGENT) + 1 == gen * 16u) {
        for (int g2 = 0; g2 < 16; ++g2) __hip_atomic_store(bar + 64 * (17 + g2), gen, __ATOMIC_RELAXED, __HIP_MEMORY_SCOPE_AGENT);
      }
    }
    while (__hip_atomic_load(bar + 64 * (17 + grp), __ATOMIC_RELAXED, __HIP_MEMORY_SCOPE_AGENT) < gen) __builtin_amdgcn_s_sleep(1);
    __builtin_amdgcn_fence(__ATOMIC_ACQUIRE, "agent");
    asm volatile("s_waitcnt vmcnt(0)" ::: "memory");
  }
  __syncthreads();
}
template <int K> DI float swz(float v) { return __int_as_float(__builtin_amdgcn_ds_swizzle(__float_as_int(v), 0x1F | (K << 10))); }
DI float half_sum(float v) { auto rr = __builtin_amdgcn_permlane32_swap(__float_as_uint(v), __float_as_uint(v), false, false); return __uint_as_float(rr[0]) + __uint_as_float(rr[1]); }
DI float half_max(float v) { auto rr = __builtin_amdgcn_permlane32_swap(__float_as_uint(v), __float_as_uint(v), false, false); return fmaxf(__uint_as_float(rr[0]), __uint_as_float(rr[1])); }
DI float wave_sum(float v) {
  v += swz<1>(v); v += swz<2>(v); v += swz<4>(v); v += swz<8>(v); v += swz<16>(v);
  return half_sum(v);
}
DI float neg_softplus(float x) { return -(fmaxf(x, 0.f) + log1pf(expf(-fabsf(x)))); }

template <bool PERM>
DI void gemm256_mainloop(f32x16 (&acc)[4][2], const bf16* A, long lda, const bf16* B, long ldb, int K, bf16* lds, int tid,
                         u32x4 (&ra)[4], u32x4 (&rb)[4], bool pre) {
  const int lane = tid & 63, wid = tid >> 6, r = lane & 31, h = lane >> 5, wm = wid >> 2, wn = wid & 3;
  bf16* As = lds;
  bf16* Bs = lds + 2 * 256 * LDT;
  const int lrow = tid >> 3, lk = (tid & 7) * 8;
  const int lrb = PERM ? (((lrow & 1) << 5) | (lrow >> 1)) : lrow;
  const unsigned oa = (unsigned)((lrow * (int)lda + lk) * 2), ob = (unsigned)((lrow * (int)ldb + lk) * 2);
  const char* Ab = (const char*)A;
  const char* Bb = (const char*)B;
  const int ns = K >> 6;
  if (!pre) {
#pragma unroll
    for (int i = 0; i < 4; ++i) { ra[i] = *(const u32x4*)(Ab + (size_t)(64 * i) * lda * 2 + oa); rb[i] = *(const u32x4*)(Bb + (size_t)(64 * i) * ldb * 2 + ob); }
  }
#pragma unroll
  for (int i = 0; i < 4; ++i) { *(u32x4*)(As + (lrow + 64 * i) * LDT + lk) = ra[i]; *(u32x4*)(Bs + (lrb + 64 * i) * LDT + lk) = rb[i]; }
  if (ns > 1) {
#pragma unroll
    for (int i = 0; i < 4; ++i) { ra[i] = *(const u32x4*)(Ab + 128 + (size_t)(64 * i) * lda * 2 + oa); rb[i] = *(const u32x4*)(Bb + 128 + (size_t)(64 * i) * ldb * 2 + ob); }
  }
  __syncthreads();
  for (int s = 0; s < ns; ++s) {
    const int cur = s & 1;
    const bf16* Ac = As + cur * 256 * LDT + (wm * 128 + r) * LDT + h * 8;
    const bf16* Bc = Bs + cur * 256 * LDT + (wn * 64 + r) * LDT + h * 8;
    const int nbuf = (cur ^ 1) * 256 * LDT;
    const size_t ko = (size_t)(s + 2) * 128;
#pragma unroll
    for (int ks = 0; ks < 4; ++ks) {
      bf16x8 a[4], b[2];
#pragma unroll
      for (int mi = 0; mi < 4; ++mi) a[mi] = *(const bf16x8*)(Ac + mi * 32 * LDT + ks * 16);
#pragma unroll
      for (int ni = 0; ni < 2; ++ni) b[ni] = *(const bf16x8*)(Bc + ni * 32 * LDT + ks * 16);
#pragma unroll
      for (int mi = 0; mi < 4; ++mi)
#pragma unroll
        for (int ni = 0; ni < 2; ++ni) acc[mi][ni] = MFMA(a[mi], b[ni], acc[mi][ni]);
      if (ks == 1 && s + 1 < ns) {
#pragma unroll
        for (int i = 0; i < 4; ++i) *(u32x4*)(As + nbuf + (lrow + 64 * i) * LDT + lk) = ra[i];
        if (s + 2 < ns) {
#pragma unroll
          for (int i = 0; i < 4; ++i) ra[i] = *(const u32x4*)(Ab + ko + (size_t)(64 * i) * lda * 2 + oa);
        }
      }
      if (ks == 2 && s + 1 < ns) {
#pragma unroll
        for (int i = 0; i < 4; ++i) *(u32x4*)(Bs + nbuf + (lrb + 64 * i) * LDT + lk) = rb[i];
        if (s + 2 < ns) {
#pragma unroll
          for (int i = 0; i < 4; ++i) rb[i] = *(const u32x4*)(Bb + ko + (size_t)(64 * i) * ldb * 2 + ob);
        }
      }
    }
    __syncthreads();
  }
}
template <int NW>
DI void gemm128_mainloop(f32x16 (&acc)[2][2], const bf16* A, long lda, const bf16* B0, long ldb0, const bf16* B1, long ldb1,
                         int K, bf16* lds, int tid, int wn0) {
  const int lane = tid & 63, wid = tid >> 6, r = lane & 31, h = lane >> 5, wm = wid >> 2, wn = (wid & 3) - wn0;
  const bool act = wn >= 0 && wn < NW;
  constexpr int NBR = 64 * NW;
  bf16* As = lds;
  bf16* Bs = lds + 2 * 128 * LDT;
  const int lrow = tid >> 3, lk = (tid & 7) * 8;
  const unsigned oa = (unsigned)((lrow * (int)lda + lk) * 2), ob0 = (unsigned)((lrow * (int)ldb0 + lk) * 2), ob1 = (unsigned)((lrow * (int)ldb1 + lk) * 2);
  const char* Ab = (const char*)A;
  const char* B0b = (const char*)B0;
  const char* B1b = (const char*)B1;
  u32x4 ra0[2], rb0[NW], ra1[2], rb1[NW];
#define CH_LOAD(RA, RB, ST) do { const size_t ko_ = (size_t)(ST) * 128; \
    _Pragma("unroll") for (int i = 0; i < 2; ++i) RA[i] = *(const u32x4*)(Ab + ko_ + (size_t)(64 * i) * lda * 2 + oa); \
    _Pragma("unroll") for (int i = 0; i < NW; ++i) RB[i] = (i < 2) ? *(const u32x4*)(B0b + ko_ + (size_t)(64 * i) * ldb0 * 2 + ob0) \
                                                                 : *(const u32x4*)(B1b + ko_ + (size_t)(64 * (i - 2)) * ldb1 * 2 + ob1); } while (0)
#define CH_STORE(RA, RB, BUF) do { \
    _Pragma("unroll") for (int i = 0; i < 2; ++i) *(u32x4*)(As + (BUF) * 128 * LDT + (lrow + 64 * i) * LDT + lk) = RA[i]; \
    _Pragma("unroll") for (int i = 0; i < NW; ++i) *(u32x4*)(Bs + (BUF) * NBR * LDT + (lrow + 64 * i) * LDT + lk) = RB[i]; } while (0)
#define CH_COMPUTE(CUR) do { if (act) { \
      const bf16* Ac = As + (CUR) * 128 * LDT + (wm * 64 + r) * LDT + h * 8; \
      const bf16* Bc = Bs + (CUR) * NBR * LDT + (wn * 64 + r) * LDT + h * 8; \
      _Pragma("unroll") for (int ks = 0; ks < 4; ++ks) { \
        const bf16x8 a0 = *(const bf16x8*)(Ac + ks * 16), a1 = *(const bf16x8*)(Ac + 32 * LDT + ks * 16); \
        const bf16x8 b0 = *(const bf16x8*)(Bc + ks * 16), b1 = *(const bf16x8*)(Bc + 32 * LDT + ks * 16); \
        acc[0][0] = MFMA(a0, b0, acc[0][0]); acc[0][1] = MFMA(a0, b1, acc[0][1]); \
        acc[1][0] = MFMA(a1, b0, acc[1][0]); acc[1][1] = MFMA(a1, b1, acc[1][1]); } } } while (0)
  const int ns = K >> 6;
  CH_LOAD(ra0, rb0, 0);
  CH_LOAD(ra1, rb1, 1);
  CH_STORE(ra0, rb0, 0);
  __syncthreads();
  for (int s = 0; s < ns; s += 2) {
    if (s + 2 < ns) CH_LOAD(ra0, rb0, s + 2);
    CH_COMPUTE(0);
    CH_STORE(ra1, rb1, 1);
    __syncthreads();
    if (s + 3 < ns) CH_LOAD(ra1, rb1, s + 3);
    CH_COMPUTE(1);
    if (s + 2 < ns) CH_STORE(ra0, rb0, 0);
    __syncthreads();
  }
#undef CH_COMPUTE
#undef CH_LOAD
#undef CH_STORE
}
DI void zero_acc(f32x16 (&acc)[2][2]) {
#pragma unroll
  for (int a = 0; a < 2; ++a)
#pragma unroll
    for (int b = 0; b < 2; ++b)
#pragma unroll
      for (int i = 0; i < 16; ++i) acc[a][b][i] = 0.f;
}
template <bool PERM = false, class Epi>
DI void gemm_tile(const bf16* A, long lda, const bf16* B, long ldb, int K, int m0, int n0, bf16* lds, Epi epi) {
  f32x16 acc[4][2];
#pragma unroll
  for (int a = 0; a < 4; ++a)
#pragma unroll
    for (int b = 0; b < 2; ++b)
#pragma unroll
      for (int i = 0; i < 16; ++i) acc[a][b][i] = 0.f;
  int tid = threadIdx.x;
  asm volatile("" : "+v"(tid));
  u32x4 ra[4], rb[4];
  gemm256_mainloop<PERM>(acc, A + (long)m0 * lda, lda, B + (long)n0 * ldb, ldb, K, lds, tid, ra, rb, false);
  const int wid = tid >> 6;
  epi(acc, m0 + (wid >> 2) * 128, n0 + (wid & 3) * 64, tid & 31, (tid >> 5) & 1);
}
template <bool PERM = false, class Map, class Epi>
DI void gemm_phase(const bf16* A, long lda, const bf16* B, long ldb, int K, int lim, int nb, bf16* lds, Map map, Epi epi) {
  int q = lbid() >> 3;
  const int qs = nb >> 3;
  if (q >= lim) return;
  int tid = ltid();
  u32x4 ra[4], rb[4];
  long aoff, boff; int mrow, ncol;
  map(q, aoff, boff, mrow, ncol);
  {
    const int lrow = tid >> 3, lk = (tid & 7) * 8;
    const unsigned oa = (unsigned)((lrow * (int)lda + lk) * 2), ob = (unsigned)((lrow * (int)ldb + lk) * 2);
    const char* Ab = (const char*)(A + aoff); const char* Bb = (const char*)(B + boff);
#pragma unroll
    for (int i = 0; i < 4; ++i) { ra[i] = *(const u32x4*)(Ab + (size_t)(64 * i) * lda * 2 + oa); rb[i] = *(const u32x4*)(Bb + (size_t)(64 * i) * ldb * 2 + ob); }
  }
  for (;;) {
    f32x16 acc[4][2];
#pragma unroll
    for (int a = 0; a < 4; ++a)
#pragma unroll
      for (int b = 0; b < 2; ++b)
#pragma unroll
        for (int i = 0; i < 16; ++i) acc[a][b][i] = 0.f;
    asm volatile("" : "+v"(tid));
    gemm256_mainloop<PERM>(acc, A + aoff, lda, B + boff, ldb, K, lds, tid, ra, rb, true);
    const int qn = q + qs;
    const bool more = qn < lim;
    const int mrow0 = mrow, ncol0 = ncol;
    if (more) {
      map(qn, aoff, boff, mrow, ncol);
      const int lrow = tid >> 3, lk = (tid & 7) * 8;
      const unsigned oa = (unsigned)((lrow * (int)lda + lk) * 2), ob = (unsigned)((lrow * (int)ldb + lk) * 2);
      const char* Ab = (const char*)(A + aoff); const char* Bb = (const char*)(B + boff);
#pragma unroll
      for (int i = 0; i < 4; ++i) { ra[i] = *(const u32x4*)(Ab + (size_t)(64 * i) * lda * 2 + oa); rb[i] = *(const u32x4*)(Bb + (size_t)(64 * i) * ldb * 2 + ob); }
    }
    const int wid = tid >> 6;
    epi(acc, mrow0 + (wid >> 2) * 128, ncol0 + (wid & 3) * 64, tid & 31, (tid >> 5) & 1);
    if (!more) break;
    q = qn;
  }
}
#define EPI_LOOP _Pragma("unroll") for (int mi = 0; mi < 4; ++mi) _Pragma("unroll") for (int ni = 0; ni < 2; ++ni) _Pragma("unroll") for (int g = 0; g < 4; ++g)
#define EPI_LOOP_PAIR _Pragma("unroll") for (int mi = 0; mi < 4; ++mi) _Pragma("unroll") for (int g = 0; g < 4; ++g)
#define CH_LOOP _Pragma("unroll") for (int mi = 0; mi < 2; ++mi) _Pragma("unroll") for (int ni = 0; ni < 2; ++ni) _Pragma("unroll") for (int g = 0; g < 4; ++g)
#define TILE_LOOP(NTM, NTN) for (int q_ = lbid() >> 3; q_ < ((NTM) >> 3) * (NTN); q_ += (nb >> 3))
#define TILE_TM(NTN) ((int)(blockIdx.x & 7) + 8 * (q_ / (NTN)))
#define TILE_TN(NTN) (q_ % (NTN))
#define MAP_STD(NTN, LDA, LDB) [&](int q_, long& ao, long& bo, int& mr, int& nc) { mr = TILE_TM(NTN) * 256; nc = TILE_TN(NTN) * 256; ao = (long)mr * (LDA); bo = (long)nc * (LDB); }
#define MAP_2D(NTN, LDA, LDB) [&](int q_, long& ao, long& bo, int& mr, int& nc) { mr = TILE_TM2(NTN) * 256; nc = TILE_TN2(NTN) * 256; ao = (long)mr * (LDA); bo = (long)nc * (LDB); }
#define TILE_TM2(NTN) ((int)(blockIdx.x & 7) + 8 * (((q_ >> 5) / ((NTN) >> 2)) * 8 + ((q_ & 31) >> 2)))
#define TILE_TN2(NTN) ((((q_ >> 5) % ((NTN) >> 2)) << 2) + (q_ & 3))

DI void epi_residual(f32x16 (&acc)[4][2], const float* xin, float* xout, const float* scale, int mw, int nw, int r, int h) {
  f2_t sc = {1.f, 1.f};
  if (scale) sc = *(const f2_t*)(scale + nw + 2 * r);
#pragma unroll
  for (int mi = 0; mi < 4; ++mi) {
    f2_t t[16];
#pragma unroll
    for (int k = 0; k < 16; ++k) t[k] = *(const f2_t*)(xin + (long)(mw + mi * 32 + (k >> 2) * 8 + h * 4 + (k & 3)) * 1024 + nw + 2 * r);
#pragma unroll
    for (int k = 0; k < 16; ++k) {
      f2_t o = {t[k][0] + acc[mi][0][k] * sc[0], t[k][1] + acc[mi][1][k] * sc[1]};
      *(f2_t*)(xout + (long)(mw + mi * 32 + (k >> 2) * 8 + h * 4 + (k & 3)) * 1024 + nw + 2 * r) = o;
    }
  }
}

template <int R, bool TO_BF16>
DI void rmsnorm_rows(const float* x, const float* gain, bf16* hout, float* fout, int nrows) {
  const int tid = ltid(), lane = tid & 63;
  const int wv = (blockIdx.x * NT + tid) >> 6, nw = gridDim.x * (NT / 64);
  for (int row = wv; row < nrows; row += R * nw) {
    f32x4 v[R][4];
#pragma unroll
    for (int q = 0; q < R; ++q) {
      const int rr = (row + q * nw < nrows) ? row + q * nw : row;
      const f32x4* xr = (const f32x4*)(x + (long)rr * 1024);
#pragma unroll
      for (int i = 0; i < 4; ++i) v[q][i] = xr[lane + 64 * i];
    }
    f32x4 gg[4];
#pragma unroll
    for (int i = 0; i < 4; ++i) gg[i] = ((const f32x4*)gain)[lane + 64 * i];
#pragma unroll
    for (int q = 0; q < R; ++q) {
      const bool valid = row + q * nw < nrows;
      const int rr = valid ? row + q * nw : row;
      float ss = 0.f;
#pragma unroll
      for (int i = 0; i < 4; ++i) ss += v[q][i][0] * v[q][i][0] + v[q][i][1] * v[q][i][1] + v[q][i][2] * v[q][i][2] + v[q][i][3] * v[q][i][3];
      ss = wave_sum(ss);
      const float rs = rsqrtf(ss * (1.f / 1024.f) + 1e-6f);
#pragma unroll
      for (int i = 0; i < 4; ++i) {
        const f32x4 o = {v[q][i][0] * rs * gg[i][0], v[q][i][1] * rs * gg[i][1], v[q][i][2] * rs * gg[i][2], v[q][i][3] * rs * gg[i][3]};
        if (!valid) continue;
        if (TO_BF16) {
          u32x2 ob = {pk2(o[0], o[1]), pk2(o[2], o[3])};
          *(u32x2*)(hout + (long)rr * 1024 + (lane + 64 * i) * 4) = ob;
        } else {
          *(f32x4*)(fout + (long)rr * 1024 + (lane + 64 * i) * 4) = o;
        }
      }
    }
  }
}
DI void phase_rmsnorm_bf16(const float* x, const float* gain, bf16* hout, int nrows) { rmsnorm_rows<4, true>(x, gain, hout, nullptr, nrows); }
DI void phase_final_norm(float* x, const float* gain, int nrows) { rmsnorm_rows<4, false>(x, gain, nullptr, x, nrows); }
DI void phase_mla_rownorm(bf16* ca, const float* qg, const float* kvg, int nrows) {
  const int tid = ltid(), lane = tid & 63;
  const int wv = (blockIdx.x * NT + tid) >> 6, nw = gridDim.x * (NT / 64);
  constexpr int R = 4;
  for (int row = wv; row < nrows; row += R * nw) {
    bf16x8 va[R], vb[R];
#pragma unroll
    for (int q = 0; q < R; ++q) {
      const int rr = (row + q * nw < nrows) ? row + q * nw : row;
      const bf16* rp = ca + (long)rr * 640;
      va[q] = *(const bf16x8*)(rp + (lane < 48 ? lane : 0) * 8);
      vb[q] = *(const bf16x8*)(rp + 384 + (lane & 31) * 8);
    }
#pragma unroll
    for (int q = 0; q < R; ++q) {
      const bool valid = row + q * nw < nrows;
      bf16* rp = ca + (long)(valid ? row + q * nw : row) * 640;
      float a[8], b[8];
      float s1 = 0.f, s2 = 0.f;
#pragma unroll
      for (int i = 0; i < 8; ++i) {
        a[i] = bf2f((bf16)va[q][i]); b[i] = bf2f((bf16)vb[q][i]);
        if (lane < 48) s1 += a[i] * a[i];
        if (lane < 32) s2 += b[i] * b[i];
      }
      s1 = wave_sum(s1); s2 = wave_sum(s2);
      const float r1 = rsqrtf(s1 * (1.f / 384.f) + 1e-6f), r2 = rsqrtf(s2 * (1.f / 256.f) + 1e-6f);
      if (valid && lane < 48) {
        const float* g = qg + lane * 8;
        u32x4 o = {pk2(a[0] * r1 * g[0], a[1] * r1 * g[1]), pk2(a[2] * r1 * g[2], a[3] * r1 * g[3]), pk2(a[4] * r1 * g[4], a[5] * r1 * g[5]), pk2(a[6] * r1 * g[6], a[7] * r1 * g[7])};
        *(u32x4*)(rp + lane * 8) = o;
      }
      if (valid && lane < 32) {
        const float* g = kvg + lane * 8;
        u32x4 o = {pk2(b[0] * r2 * g[0], b[1] * r2 * g[1]), pk2(b[2] * r2 * g[2], b[3] * r2 * g[3]), pk2(b[4] * r2 * g[4], b[5] * r2 * g[5]), pk2(b[6] * r2 * g[6], b[7] * r2 * g[7])};
        *(u32x4*)(rp + 384 + lane * 8) = o;
      }
    }
  }
}
DI void phase_onorm(bf16* of, const bf16* ob, int ntok) {
  const int tid = ltid(), lane = tid & 63;
  const int wv = (blockIdx.x * NT + tid) >> 6, nw = gridDim.x * (NT / 64);
  constexpr int R = 4;
  for (int it = wv; it < ntok * 4; it += R * nw) {
    bf16x8 v1[R], v2[R];
#pragma unroll
    for (int q = 0; q < R; ++q) {
      const int ii = (it + q * nw < ntok * 4) ? it + q * nw : it;
      const long off = (long)ii * 512 + lane * 8;
      v1[q] = *(const bf16x8*)(of + off); v2[q] = *(const bf16x8*)(ob + off);
    }
#pragma unroll
    for (int q = 0; q < R; ++q) {
      const bool valid = it + q * nw < ntok * 4;
      const long off = (long)(valid ? it + q * nw : it) * 512 + lane * 8;
      float a[8];
      float s = 0.f;
#pragma unroll
      for (int i = 0; i < 8; ++i) { a[i] = bf2f((bf16)v1[q][i]) + bf2f((bf16)v2[q][i]); s += a[i]; }
      const float mu = wave_sum(s) * (1.f / 512.f);
      float qq = 0.f;
#pragma unroll
      for (int i = 0; i < 8; ++i) { a[i] -= mu; qq += a[i] * a[i]; }
      const float rs = rsqrtf(wave_sum(qq) * (1.f / 512.f) + 1e-6f);
      u32x4 o = {pk2(a[0] * rs, a[1] * rs), pk2(a[2] * rs, a[3] * rs), pk2(a[4] * rs, a[5] * rs), pk2(a[6] * rs, a[7] * rs)};
      if (valid) *(u32x4*)(of + off) = o;
    }
  }
}
DI void phase_pool(const bf16* hh, bf16* pl, int ntok, int S) {
  const long total = (long)ntok * 128;
  const int tid = ltid();
  for (long it = (long)blockIdx.x * NT + tid; it < total; it += (long)gridDim.x * NT) {
    const int t = (int)(it >> 7), ch = (int)(it & 127);
    const int s = t & (S - 1), sb = t - s;
    const int w = 2 << (ch >> 5);
    int lo = s - (w >> 1); if (lo < 0) lo = 0;
    int hi = s + (w >> 1) - 1; if (hi > S - 1) hi = S - 1;
    bf16x8 v[16];
#pragma unroll
    for (int k = 0; k < 16; ++k) {
      const int rr = (lo + k <= hi) ? lo + k : hi;
      if (k < w) v[k] = *(const bf16x8*)(hh + (long)(sb + rr) * 1024 + ch * 8);
      else v[k] = (bf16x8){0, 0, 0, 0, 0, 0, 0, 0};
    }
    const bf16x8 c = *(const bf16x8*)(hh + (long)t * 1024 + ch * 8);
    float acc[8];
#pragma unroll
    for (int i = 0; i < 8; ++i) acc[i] = 0.f;
#pragma unroll
    for (int k = 0; k < 16; ++k) {
      if (lo + k <= hi) {
#pragma unroll
        for (int i = 0; i < 8; ++i) acc[i] += bf2f((bf16)v[k][i]);
      }
    }
    const float ic = 1.f / (float)(hi - lo + 1);
    float o[8];
#pragma unroll
    for (int i = 0; i < 8; ++i) o[i] = acc[i] * ic - bf2f((bf16)c[i]);
    u32x4 ov = {pk2(o[0], o[1]), pk2(o[2], o[3]), pk2(o[4], o[5]), pk2(o[6], o[7])};
    *(u32x4*)(pl + (long)t * 1024 + ch * 8) = ov;
  }
}

DI void sincos_d(double x, float& s, float& c) {
  const double x2 = x * x;
  double ts = 1.0, tc = 1.0;
#pragma unroll
  for (int k = 14; k >= 1; --k) {
    ts = 1.0 - ts * x2 * (1.0 / (double)((2 * k) * (2 * k + 1)));
    tc = 1.0 - tc * x2 * (1.0 / (double)((2 * k - 1) * (2 * k)));
  }
  s = (float)(x * ts); c = (float)tc;
}
DI void phase_prologue(KP pp, float* ldsf) {
  const int tid = ltid();
  bf16* WB = (bf16*)pp->ws;
  for (int j = 0; j < pp->njobs; ++j) {
    const float* src = pp->jobs[j].src;
    bf16* dst = WB + pp->jobs[j].dst;
    const int K = pp->jobs[j].K, N = pp->jobs[j].N, perm = pp->jobs[j].perm;
    const int tk = K >> 6, tn = N >> 6;
    for (int tile = blockIdx.x; tile < tk * tn; tile += gridDim.x) {
      const int k0 = (tile % tk) * 64, n0 = (tile / tk) * 64;
#pragma unroll 4
      for (int i = 0; i < 8; ++i) {
        const int ky = (tid >> 6) + 8 * i, nx = tid & 63;
        ldsf[ky * 65 + nx] = src[(long)(k0 + ky) * N + n0 + nx];
      }
      __syncthreads();
#pragma unroll 4
      for (int i = 0; i < 8; ++i) {
        const int ny = (tid >> 6) + 8 * i, kx = tid & 63;
        int n = n0 + ny;
        if (perm) { const int d = n & 255; n = (n & ~255) | (((d >> 5) & 3) << 6) | ((d >> 7) << 5) | (d & 31); }
        dst[(long)n * K + k0 + kx] = tobf(ldsf[kx * 65 + ny]);
      }
      __syncthreads();
    }
  }
  float2* tabM = (float2*)(pp->ws + OFF_TABM);
  float2* tabR = (float2*)(pp->ws + OFF_TABR);
  const long nM = 16384L * 32, nR = 16384L * 128;
  for (long it = (long)blockIdx.x * NT + tid; it < nM + nR; it += (long)gridDim.x * NT) {
    int pos, i; double frac;
    if (it < nM) { pos = (int)(it >> 5); i = (int)(it & 31); frac = (double)(2 * i) / 64.0; }
    else { const long k = it - nM; pos = (int)(k >> 7); i = (int)(k & 127); frac = (double)(2 * i) / 256.0; }
    const float inv = (float)exp(-frac * 9.210340371976184);
    const float ang = (float)pos * inv;
    const double a = (double)ang;
    const double kk = rint(a * 0.15915494309189535);
    const double rr = fma(-kk, 6.283185307179586, a);
    float s, c;
    sincos_d(rr, s, c);
    if (it < nM) tabM[it] = make_float2(c, s); else tabR[it - nM] = make_float2(c, s);
  }
}

constexpr int ATT_VLD = 68;
constexpr int ATT_KSLOT = 64 * 200, ATT_VSLOT = 128 * ATT_VLD, ATT_VBASE = 2 * ATT_KSLOT;
DI void attn_pv(f32x16 (&oT)[4], const bf16* Vs, const bf16x8 (&pb)[4], int r, int h) {
#pragma unroll
  for (int d0 = 0; d0 < 4; ++d0) {
    const bf16* vb = Vs + (32 * d0 + r) * ATT_VLD + 4 * h;
#pragma unroll
    for (int s = 0; s < 4; ++s) {
      const int kbase = (s >> 1) * 32 + (s & 1) * 16;
      const s16x4 lo = *(const s16x4*)(vb + kbase), hi = *(const s16x4*)(vb + kbase + 8);
      const bf16x8 va = __builtin_shufflevector(lo, hi, 0, 1, 2, 3, 4, 5, 6, 7);
      oT[d0] = MFMA(va, pb[s], oT[d0]);
    }
  }
}
DI void attn_tile(const bf16* Q, const bf16* Kn, const bf16* Kp, const bf16* Vt, bf16* O, int S, bf16* lds) {
  int tid = threadIdx.x;
  asm volatile("" : "+v"(tid));
  const int lane = tid & 63, wid = tid >> 6, r = lane & 31, h = lane >> 5;
  constexpr bool late = false;
  constexpr float C = 0.07216878364870322f * 1.4426950408889634f;
  bf16x8 qr[12];
  {
    const bf16* qp = Q + (long)(wid * 32 + r) * 1536 + h * 8;
#pragma unroll
    for (int d0 = 0; d0 < 12; ++d0) qr[d0] = *(const bf16x8*)(qp + d0 * 16);
  }
  f32x16 oT[4];
#pragma unroll
  for (int d0 = 0; d0 < 4; ++d0)
#pragma unroll
    for (int i = 0; i < 16; ++i) oT[d0][i] = 0.f;
  float m = -1e30f, l = 0.f;
  u32x4 skA[2], spA, svA[2], skB[2], spB, svB[2];
  const unsigned okn = (unsigned)(((tid >> 4) * 1024 + (tid & 15) * 8) * 2);
  const unsigned okp = (unsigned)(((tid >> 3) * 64 + (tid & 7) * 8) * 2);
  const unsigned ovt = (unsigned)(((tid >> 3) * 64 + (tid & 7) * 8) * 2);
  const int sko = (tid >> 4) * 200 + (tid & 15) * 8, spo = (tid >> 3) * 200 + 128 + (tid & 7) * 8, svo = (tid >> 3) * ATT_VLD + (tid & 7) * 8;
#define ATT_LOAD(X, key0) do { \
    const char* kn_ = (const char*)(Kn + (long)(key0) * 1024); const char* kp_ = (const char*)(Kp + (long)(key0) * 64); const char* vt_ = (const char*)(Vt + (long)(key0) * 128); \
    sk##X[0] = *(const u32x4*)(kn_ + okn); sk##X[1] = *(const u32x4*)(kn_ + (size_t)32 * 2048 + okn); \
    sp##X = *(const u32x4*)(kp_ + okp); \
    sv##X[0] = *(const u32x4*)(vt_ + ovt); sv##X[1] = *(const u32x4*)(vt_ + (size_t)64 * 64 * 2 + ovt); } while (0)
#define ATT_STORE(X, kslot, vslot) do { bf16* k_ = lds + (kslot) * ATT_KSLOT; bf16* v_ = lds + ATT_VBASE + (vslot) * ATT_VSLOT; \
    *(u32x4*)(k_ + sko) = sk##X[0]; *(u32x4*)(k_ + sko + 32 * 200) = sk##X[1]; *(u32x4*)(k_ + spo) = sp##X; \
    *(u32x2*)(v_ + svo) = (u32x2){sv##X[0][0], sv##X[0][1]}; *(u32x2*)(v_ + svo + 4) = (u32x2){sv##X[0][2], sv##X[0][3]}; \
    *(u32x2*)(v_ + svo + 64 * ATT_VLD) = (u32x2){sv##X[1][0], sv##X[1][1]}; *(u32x2*)(v_ + svo + 64 * ATT_VLD + 4) = (u32x2){sv##X[1][2], sv##X[1][3]}; } while (0)
  const int nt = S >> 6;
  __syncthreads();
  ATT_LOAD(A, 0);
  ATT_STORE(A, 0, 0);
  if (nt > 1) ATT_LOAD(B, 64);
  __syncthreads();
  bf16x8 pb[4];
#pragma unroll
  for (int i = 0; i < 4; ++i)
#pragma unroll
    for (int k = 0; k < 8; ++k) pb[i][k] = 0;
  int vs_cur = 0;
  int vs_prev = 2;
  for (int j = 0; j < nt; ++j) {
    {
    const bool more = (j + 1 < nt);
    const bool more2 = (j + 2 < nt);
    const bf16* Ks = lds + (j & 1) * ATT_KSLOT;
    if (more2) ATT_LOAD(A, (j + 2) * 64);
    if (late && j > 0) attn_pv(oT, lds + ATT_VBASE + vs_prev * ATT_VSLOT, pb, r, h);
    f32x16 p0, p1;
#pragma unroll
    for (int i = 0; i < 16; ++i) { p0[i] = 0.f; p1[i] = 0.f; }
    const bf16* kb = Ks + r * 200 + h * 8;
#pragma unroll
    for (int d0 = 0; d0 < 12; ++d0) {
      const bf16x8 ka0 = *(const bf16x8*)(kb + d0 * 16), ka1 = *(const bf16x8*)(kb + 32 * 200 + d0 * 16);
      p0 = MFMA(ka0, qr[d0], p0);
      p1 = MFMA(ka1, qr[d0], p1);
    }
    float mx = p0[0];
#pragma unroll
    for (int i = 1; i < 16; ++i) mx = fmaxf(mx, p0[i]);
#pragma unroll
    for (int i = 0; i < 16; ++i) mx = fmaxf(mx, p1[i]);
    mx = half_max(mx);
    if (__any((mx - m) * C > 11.5f)) {
      const float mn = fmaxf(m, mx);
      const float alpha = __builtin_amdgcn_exp2f((m - mn) * C);
      m = mn;
      l *= alpha;
#pragma unroll
      for (int d0 = 0; d0 < 4; ++d0)
#pragma unroll
        for (int i = 0; i < 16; ++i) oT[d0][i] *= alpha;
    }
    const float mc = m * C;
    float ps = 0.f;
#pragma unroll
    for (int i = 0; i < 16; ++i) { p0[i] = __builtin_amdgcn_exp2f(p0[i] * C - mc); ps += p0[i]; }
#pragma unroll
    for (int i = 0; i < 16; ++i) { p1[i] = __builtin_amdgcn_exp2f(p1[i] * C - mc); ps += p1[i]; }
    ps = half_sum(ps);
    l += ps;
    {
      u32x4 w0 = {pk2(p0[0], p0[1]), pk2(p0[2], p0[3]), pk2(p0[4], p0[5]), pk2(p0[6], p0[7])};
      u32x4 w1 = {pk2(p0[8], p0[9]), pk2(p0[10], p0[11]), pk2(p0[12], p0[13]), pk2(p0[14], p0[15])};
      u32x4 w2 = {pk2(p1[0], p1[1]), pk2(p1[2], p1[3]), pk2(p1[4], p1[5]), pk2(p1[6], p1[7])};
      u32x4 w3 = {pk2(p1[8], p1[9]), pk2(p1[10], p1[11]), pk2(p1[12], p1[13]), pk2(p1[14], p1[15])};
      pb[0] = __builtin_bit_cast(bf16x8, w0); pb[1] = __builtin_bit_cast(bf16x8, w1);
      pb[2] = __builtin_bit_cast(bf16x8, w2); pb[3] = __builtin_bit_cast(bf16x8, w3);
    }
    const int vs_next = (vs_cur == 2) ? 0 : vs_cur + 1;
    if (!late) attn_pv(oT, lds + ATT_VBASE + vs_cur * ATT_VSLOT, pb, r, h);
    if (more) ATT_STORE(B, (j + 1) & 1, vs_next);
    vs_prev = vs_cur; vs_cur = vs_next;
    __syncthreads();
    }
    if (++j >= nt) break;
    {
    const bool more = (j + 1 < nt);
    const bool more2 = (j + 2 < nt);
    const bf16* Ks = lds + (j & 1) * ATT_KSLOT;
    if (more2) ATT_LOAD(B, (j + 2) * 64);
    if (late && j > 0) attn_pv(oT, lds + ATT_VBASE + vs_prev * ATT_VSLOT, pb, r, h);
    f32x16 p0, p1;
#pragma unroll
    for (int i = 0; i < 16; ++i) { p0[i] = 0.f; p1[i] = 0.f; }
    const bf16* kb = Ks + r * 200 + h * 8;
#pragma unroll
    for (int d0 = 0; d0 < 12; ++d0) {
      const bf16x8 ka0 = *(const bf16x8*)(kb + d0 * 16), ka1 = *(const bf16x8*)(kb + 32 * 200 + d0 * 16);
      p0 = MFMA(ka0, qr[d0], p0);
      p1 = MFMA(ka1, qr[d0], p1);
    }
    float mx = p0[0];
#pragma unroll
    for (int i = 1; i < 16; ++i) mx = fmaxf(mx, p0[i]);
#pragma unroll
    for (int i = 0; i < 16; ++i) mx = fmaxf(mx, p1[i]);
    mx = half_max(mx);
    if (__any((mx - m) * C > 11.5f)) {
      const float mn = fmaxf(m, mx);
      const float alpha = __builtin_amdgcn_exp2f((m - mn) * C);
      m = mn;
      l *= alpha;
#pragma unroll
      for (int d0 = 0; d0 < 4; ++d0)
#pragma unroll
        for (int i = 0; i < 16; ++i) oT[d0][i] *= alpha;
    }
    const float mc = m * C;
    float ps = 0.f;
#pragma unroll
    for (int i = 0; i < 16; ++i) { p0[i] = __builtin_amdgcn_exp2f(p0[i] * C - mc); ps += p0[i]; }
#pragma unroll
    for (int i = 0; i < 16; ++i) { p1[i] = __builtin_amdgcn_exp2f(p1[i] * C - mc); ps += p1[i]; }
    ps = half_sum(ps);
    l += ps;
    {
      u32x4 w0 = {pk2(p0[0], p0[1]), pk2(p0[2], p0[3]), pk2(p0[4], p0[5]), pk2(p0[6], p0[7])};
      u32x4 w1 = {pk2(p0[8], p0[9]), pk2(p0[10], p0[11]), pk2(p0[12], p0[13]), pk2(p0[14], p0[15])};
      u32x4 w2 = {pk2(p1[0], p1[1]), pk2(p1[2], p1[3]), pk2(p1[4], p1[5]), pk2(p1[6], p1[7])};
      u32x4 w3 = {pk2(p1[8], p1[9]), pk2(p1[10], p1[11]), pk2(p1[12], p1[13]), pk2(p1[14], p1[15])};
      pb[0] = __builtin_bit_cast(bf16x8, w0); pb[1] = __builtin_bit_cast(bf16x8, w1);
      pb[2] = __builtin_bit_cast(bf16x8, w2); pb[3] = __builtin_bit_cast(bf16x8, w3);
    }
    const int vs_next = (vs_cur == 2) ? 0 : vs_cur + 1;
    if (!late) attn_pv(oT, lds + ATT_VBASE + vs_cur * ATT_VSLOT, pb, r, h);
    if (more) ATT_STORE(A, (j + 1) & 1, vs_next);
    vs_prev = vs_cur; vs_cur = vs_next;
    __syncthreads();
    }
  }
  if (late) attn_pv(oT, lds + ATT_VBASE + vs_prev * ATT_VSLOT, pb, r, h);
#undef ATT_LOAD
#undef ATT_STORE
  const float il = 1.f / l;
  bf16* op = O + (long)(wid * 32 + r) * 1024 + 4 * h;
#pragma unroll
  for (int d0 = 0; d0 < 4; ++d0)
#pragma unroll
    for (int g = 0; g < 4; ++g) {
      u32x2 o = {pk2(oT[d0][4 * g] * il, oT[d0][4 * g + 1] * il), pk2(oT[d0][4 * g + 2] * il, oT[d0][4 * g + 3] * il)};
      *(u32x2*)(op + 32 * d0 + 8 * g) = o;
    }
}

constexpr int ST_LD = 264;
DI void chain_task(const bf16* RQ, const bf16* RKT, const bf16* RVT, bf16* Od, float* stF,
                   int tu0, int nsteps, int head, int dir, int slice, float lg, bf16* lds, int init_from_slot, int state_only) {
  int tid = ltid();
  bf16* STL = lds;
  bf16* W = lds + 128 * ST_LD;
  f32x16 sacc[2][2];
  {
    const int t2 = tid;
    if (init_from_slot) {
      const float* sp_ = stF + t2;
      CH_LOOP {
#pragma unroll
        for (int e = 0; e < 4; ++e) sacc[mi][ni][4 * g + e] = sp_[((mi * 2 + ni) * 16 + 4 * g + e) * NT];
      }
    } else {
      zero_acc(sacc);
    }
  }
  const float cdec = __expf(128.f * lg);
  __syncthreads();
  for (int step = 0; step <= nsteps; ++step) {
    asm volatile("" : "+v"(tid));
    const int lane = tid & 63, wid = tid >> 6, r = lane & 31, h = lane >> 5, wm = wid >> 2, wn = wid & 3;
    const int lrow = tid >> 3, lk = (tid & 7) * 8;
    if (step == nsteps) break;
    if (!state_only) {
      CH_LOOP {
#pragma unroll
        for (int e = 0; e < 4; ++e)
          STL[(wm * 64 + mi * 32 + g * 8 + h * 4 + e) * ST_LD + wn * 64 + ni * 32 + r] = tobf(sacc[mi][ni][4 * g + e]);
      }
    }
    const int c = dir ? (nsteps - 1 - step) : step;
    const int tc = tu0 + c * 128;
    const char* Vb = (const char*)(RVT + ((long)(tc >> 7) * 2048 + head * 512 + slice * 128) * 128);
    const char* Kb = (const char*)(RKT + ((long)(tc >> 7) * 1024 + head * 256) * 128);
    const unsigned o3 = (unsigned)((lrow * 128 + lk) * 2);
    u32x4 rv[2][2], rk[2][4];
#pragma unroll
    for (int st = 0; st < 2; ++st) {
#pragma unroll
      for (int i = 0; i < 2; ++i) rv[st][i] = *(const u32x4*)(Vb + (size_t)(64 * i) * 256 + st * 128 + o3);
#pragma unroll
      for (int i = 0; i < 4; ++i) rk[st][i] = *(const u32x4*)(Kb + (size_t)(64 * i) * 256 + st * 128 + o3);
    }
    if (!state_only) {
      const char* Qb = (const char*)(RQ + (long)tc * 1024 + head * 256);
      const unsigned oq = (unsigned)((lrow * 1024 + lk) * 2);
      u32x4 rq[4][2];
#pragma unroll
      for (int s = 0; s < 4; ++s)
#pragma unroll
        for (int i = 0; i < 2; ++i) rq[s][i] = *(const u32x4*)(Qb + (size_t)s * 128 + (size_t)(64 * i) * 2048 + oq);
#pragma unroll
      for (int s = 0; s < 4; ++s)
#pragma unroll
        for (int i = 0; i < 2; ++i) *(u32x4*)(W + (lrow + 64 * i) * ST_LD + s * 64 + lk) = rq[s][i];
      __syncthreads();
      bf16* ob = Od + (long)(tc + wm * 64 + h * 4) * 2048 + head * 512 + slice * 128 + wn * 32 + r;
      bf16 t[2][16];
#pragma unroll
      for (int mi = 0; mi < 2; ++mi)
#pragma unroll
        for (int k = 0; k < 16; ++k) t[mi][k] = ob[(long)(mi * 32 + (k >> 2) * 8 + (k & 3)) * 2048];
      f32x16 qacc[2];
#pragma unroll
      for (int mi = 0; mi < 2; ++mi)
#pragma unroll
        for (int k = 0; k < 16; ++k) qacc[mi][k] = 0.f;
      {
        const bf16* Ac = W + (wm * 64 + r) * ST_LD + h * 8;
        const bf16* Bc = STL + (wn * 32 + r) * ST_LD + h * 8;
#pragma unroll
        for (int kk = 0; kk < 16; ++kk) {
          const bf16x8 a0 = *(const bf16x8*)(Ac + kk * 16), a1 = *(const bf16x8*)(Ac + 32 * ST_LD + kk * 16);
          const bf16x8 b0 = *(const bf16x8*)(Bc + kk * 16);
          qacc[0] = MFMA(a0, b0, qacc[0]);
          qacc[1] = MFMA(a1, b0, qacc[1]);
        }
      }
#pragma unroll
      for (int mi = 0; mi < 2; ++mi)
#pragma unroll
        for (int k = 0; k < 16; ++k) {
          const int i = wm * 64 + mi * 32 + (k >> 2) * 8 + h * 4 + (k & 3);
          const float qd = __expf(lg * (float)(dir ? (128 - i) : (i + 1)));
          ob[(long)(mi * 32 + (k >> 2) * 8 + (k & 3)) * 2048] = tobf(bf2f(t[mi][k]) + qd * qacc[mi][k]);
        }
      __syncthreads();
    }
#pragma unroll
    for (int mi = 0; mi < 2; ++mi)
#pragma unroll
      for (int ni = 0; ni < 2; ++ni)
#pragma unroll
        for (int k = 0; k < 16; ++k) sacc[mi][ni][k] *= cdec;
#pragma unroll
    for (int st = 0; st < 2; ++st) {
      bf16* As3 = W;
      bf16* Bs3 = W + 128 * LDT;
#pragma unroll
      for (int i = 0; i < 2; ++i) *(u32x4*)(As3 + (lrow + 64 * i) * LDT + lk) = rv[st][i];
#pragma unroll
      for (int i = 0; i < 4; ++i) *(u32x4*)(Bs3 + (lrow + 64 * i) * LDT + lk) = rk[st][i];
      __syncthreads();
      const bf16* Ac = As3 + (wm * 64 + r) * LDT + h * 8;
      const bf16* Bc = Bs3 + (wn * 64 + r) * LDT + h * 8;
#pragma unroll
      for (int ks = 0; ks < 4; ++ks) {
        const bf16x8 a0 = *(const bf16x8*)(Ac + ks * 16), a1 = *(const bf16x8*)(Ac + 32 * LDT + ks * 16);
        const bf16x8 b0 = *(const bf16x8*)(Bc + ks * 16), b1 = *(const bf16x8*)(Bc + 32 * LDT + ks * 16);
        sacc[0][0] = MFMA(a0, b0, sacc[0][0]); sacc[0][1] = MFMA(a0, b1, sacc[0][1]);
        sacc[1][0] = MFMA(a1, b0, sacc[1][0]); sacc[1][1] = MFMA(a1, b1, sacc[1][1]);
      }
      __syncthreads();
    }
  }
  if (state_only) {
    float* sp_ = stF + tid;
    CH_LOOP {
#pragma unroll
      for (int e = 0; e < 4; ++e) sp_[((mi * 2 + ni) * 16 + 4 * g + e) * NT] = sacc[mi][ni][4 * g + e];
    }
  }
  __syncthreads();
}

DI void ret_intra_item(const bf16* RQ, const bf16* RK, const bf16* RVT, bf16* Od, bf16* att, int tc, int head, int dir, float lg, bf16* lds) {
  int tid = ltid();
  const int lane = tid & 63, wid = tid >> 6, r = lane & 31, h = lane >> 5, wm = wid >> 2, wn = wid & 3;
  const bf16* Qc = RQ + (long)tc * 1024 + head * 256;
  const bf16* Kc = RK + (long)tc * 1024 + head * 256;
  f32x16 acc[2][2];
  zero_acc(acc);
  gemm128_mainloop<2>(acc, Qc, 1024, Kc, 1024, Kc, 1024, 256, lds, tid, 0);
  if (wn < 2) {
    CH_LOOP {
#pragma unroll
      for (int e = 0; e < 4; ++e) {
        const int i = wm * 64 + mi * 32 + g * 8 + h * 4 + e, jx = wn * 64 + ni * 32 + r;
        const int diff = dir ? (jx - i) : (i - jx);
        const float v = diff >= 0 ? acc[mi][ni][4 * g + e] * __expf(lg * (float)diff) : 0.f;
        att[i * 128 + jx] = tobf(v);
      }
    }
  }
  __syncthreads();
#pragma unroll 1
  for (int vh = 0; vh < 2; ++vh) {
    const bf16* Vc = RVT + ((long)(tc >> 7) * 2048 + head * 512 + vh * 256) * 128;
    zero_acc(acc);
    gemm128_mainloop<4>(acc, att, 128, Vc, 128, Vc + 128 * 128, 128, 128, lds, tid, 0);
    CH_LOOP {
#pragma unroll
      for (int e = 0; e < 4; ++e) {
        const int i = wm * 64 + mi * 32 + g * 8 + h * 4 + e;
        Od[(long)(tc + i) * 2048 + head * 512 + vh * 256 + wn * 64 + ni * 32 + r] = tobf(acc[mi][ni][4 * g + e]);
      }
    }
  }
  __syncthreads();
}

DI void phase_chain_combine(char* SCR, const float* lgf_raw, const float* lgb_raw) {
  const int tid = ltid();
  const long total = 32L * 32768;
  for (long it = (long)blockIdx.x * NT + tid; it < total; it += (long)gridDim.x * NT) {
    const int hds = (int)(it >> 15), e = (int)(it & 32767);
    const int slice = hds & 3, dir = (hds >> 2) & 1, head = hds >> 3;
    const float lg = neg_softplus(dir ? lgb_raw[head] : lgf_raw[head]);
    const float cseg = __expf(2048.f * lg);
    const int k = e >> 9, t = e & 511;
    const int mi = k >> 5, ni = (k >> 4) & 1, g = (k >> 2) & 3, ee = k & 3;
    const int wid = t >> 6, hh = (t >> 5) & 1, r = t & 31;
    const int v = (wid >> 2) * 64 + mi * 32 + g * 8 + hh * 4 + ee, d = (wid & 3) * 64 + ni * 32 + r;
    float en[8];
#pragma unroll
    for (int s = 0; s < 8; ++s) {
      const int u = dir ? (7 - s) : s;
      const char* slot = SCR + (long)((((u * 4 + head) * 2 + dir) * 4) + slice) * 163840;
      en[s] = (s < 7) ? ((const float*)(slot + 32768))[e] : 0.f;
    }
    float prev = 0.f;
#pragma unroll
    for (int s = 0; s < 8; ++s) {
      const int u = dir ? (7 - s) : s;
      char* slot = SCR + (long)((((u * 4 + head) * 2 + dir) * 4) + slice) * 163840;
      ((float*)(slot + 32768))[e] = prev;
      prev = cseg * prev + en[s];
    }
  }
}

__global__ void __launch_bounds__(512, 2) mega(Params p) {
  __shared__ __attribute__((aligned(16))) char smem[SMEM_BYTES];
  cg::grid_group grid = cg::this_grid();
  bf16* lds = (bf16*)smem;
  KP pp = kargs();
  char* ws = pp->ws;
  const bf16* WB = (const bf16*)ws;
  const float2* tabM = (const float2*)(ws + OFF_TABM);
  const float2* tabR = (const float2*)(ws + OFF_TABR);
  const int nb = gridDim.x, bid = blockIdx.x;

  unsigned bar_gen = 0;
  phase_prologue(pp, (float*)smem);
  grid.sync();

  for (int L = 0; L < 4; ++L) {
    const int kind = L % 3, jl = L / 3;
    if (kind == 0) {
#define MLA_CTX \
        KP pp = kargs(); char* SB = pp->ws + OFF_S; \
        const bf16* WA = (const bf16*)pp->ws + jl * MLA_SZ; const bf16* WUQ = WA + MLA_WUQ; const bf16* WUKV = WA + MLA_WUKV; const bf16* WO = WA + MLA_WO; \
        const float2* tabM = (const float2*)(pp->ws + OFF_TABM); \
        const int S = hf ? 16384 : 2048; \
        const float* xin = (L == 0) ? pp->in[hf] : (pp->out + (long)hf * TH * 1024); \
        float* xout = pp->out + (long)hf * TH * 1024; \
        bf16* H = (bf16*)SB; bf16* CA = (bf16*)(SB + 64 * MiB); bf16* KPE = (bf16*)(SB + 104 * MiB); bf16* Q = (bf16*)(SB + 108 * MiB); \
        bf16* KN = (bf16*)(SB + 204 * MiB); bf16* VT = (bf16*)(SB + 268 * MiB); \
        (void)WA; (void)WUQ; (void)WUKV; (void)WO; (void)tabM; (void)S; (void)xin; (void)xout; (void)H; (void)CA; (void)KPE; (void)Q; (void)KN; (void)VT;
      for (int hf = 0; hf < 2; ++hf) {
        { MLA_CTX phase_rmsnorm_bf16(xin, pp->in[2] + L * 1024, H, TH); }
        gsync(bar_gen);
        { MLA_CTX
        gemm_phase(H, 1024, WA, 1024, 1024, 16 * 3, nb, lds, MAP_STD(3, 1024, 1024),
            [&](f32x16 (&acc)[4][2], int mw, int nw, int r, int h) {
              if (nw < 640) {
                EPI_LOOP {
#pragma unroll
                  for (int e = 0; e < 4; ++e) CA[(long)(mw + mi * 32 + g * 8 + h * 4 + e) * 640 + nw + ni * 32 + r] = tobf(acc[mi][ni][4 * g + e]);
                }
              } else if (nw == 640) {
                EPI_LOOP_PAIR {
#pragma unroll
                  for (int e = 0; e < 4; ++e) {
                    const int t = mw + mi * 32 + g * 8 + h * 4 + e;
                    const float2 cs = tabM[(long)(t & (S - 1)) * 32 + r];
                    const float a = acc[mi][0][4 * g + e], b = acc[mi][1][4 * g + e];
                    KPE[(long)t * 64 + r] = tobf(a * cs.x - b * cs.y);
                    KPE[(long)t * 64 + 32 + r] = tobf(a * cs.y + b * cs.x);
                  }
                }
              }
            });
        }
        gsync(bar_gen);
        { MLA_CTX phase_mla_rownorm(CA, pp->in[5] + jl * 384, pp->in[8] + jl * 256, TH); }
        gsync(bar_gen);
        { MLA_CTX
        gemm_phase(CA, 640, WUQ, 384, 384, 16 * 6, nb, lds, MAP_STD(6, 640, 384),
              [&](f32x16 (&acc)[4][2], int mw, int nw, int r, int h) {
                if ((nw % 192) != 128) {
                  EPI_LOOP {
#pragma unroll
                    for (int e = 0; e < 4; ++e) Q[(long)(mw + mi * 32 + g * 8 + h * 4 + e) * 1536 + nw + ni * 32 + r] = tobf(acc[mi][ni][4 * g + e]);
                  }
                } else {
                  EPI_LOOP_PAIR {
#pragma unroll
                    for (int e = 0; e < 4; ++e) {
                      const int t = mw + mi * 32 + g * 8 + h * 4 + e;
                      const float2 cs = tabM[(long)(t & (S - 1)) * 32 + r];
                      const float a = acc[mi][0][4 * g + e], b = acc[mi][1][4 * g + e];
                      Q[(long)t * 1536 + nw + r] = tobf(a * cs.x - b * cs.y);
                      Q[(long)t * 1536 + nw + 32 + r] = tobf(a * cs.y + b * cs.x);
                    }
                  }
                }
              });
        gemm_phase(CA + 384, 640, WUKV, 256, 256, 16 * 8, nb, lds, MAP_STD(8, 640, 256),
              [&](f32x16 (&acc)[4][2], int mw, int nw, int r, int h) {
                const int head = nw >> 8, w = nw & 255;
                if (w < 128) {
                  EPI_LOOP {
#pragma unroll
                    for (int e = 0; e < 4; ++e) KN[(long)(mw + mi * 32 + g * 8 + h * 4 + e) * 1024 + head * 128 + w + ni * 32 + r] = tobf(acc[mi][ni][4 * g + e]);
                  }
                } else {
                  EPI_LOOP {
                    const int t = mw + mi * 32 + g * 8 + h * 4;
                    const int b = t / S, s = t & (S - 1);
                    const int d = (w - 128) + ni * 32 + r;
                    u32x2 o = {pk2(acc[mi][ni][4 * g], acc[mi][ni][4 * g + 1]), pk2(acc[mi][ni][4 * g + 2], acc[mi][ni][4 * g + 3])};
                    *(u32x2*)(VT + (long)(b * 8 + head) * 128 * S + (long)(s >> 6) * 8192 + d * 64 + (s & 63)) = o;
                  }
                }
              });
        }
        gsync(bar_gen);
        { MLA_CTX
          const int nqb = S >> 8;
          for (int q_ = lbid() >> 3; q_ < 128; q_ += (nb >> 3)) {
            const int qb = q_ % nqb, bh = (int)(blockIdx.x & 7) + 8 * (q_ / nqb), head = bh & 7, b = bh >> 3;
            attn_tile(Q + (long)(b * S + qb * 256) * 1536 + head * 192, KN + (long)(b * S) * 1024 + head * 128, KPE + (long)(b * S) * 64,
                      VT + (long)((b * 8 + head) * 128) * S, H + (long)(b * S + qb * 256) * 1024 + head * 128, S, lds);
          }
        }
        gsync(bar_gen);
        { MLA_CTX
        gemm_phase<true>(H, 1024, WO, 1024, 1024, 16 * 4, nb, lds, MAP_STD(4, 1024, 1024),
            [&](f32x16 (&acc)[4][2], int mw, int nw, int r, int h) {
              epi_residual(acc, xin, xout, nullptr, mw, nw, r, h);
            });
        }
        gsync(bar_gen);
      }
#undef MLA_CTX
    } else if (kind == 1) {
      const bf16* WQKV = WB + WB_RET;
      const bf16* WG = WQKV + RET_WG;
      const bf16* WOr = WQKV + RET_WO;
      for (int qt = 0; qt < 4; ++qt) {
        KP pp = kargs(); char* SB = pp->ws + OFF_S;
        const int S = qt < 2 ? 2048 : 16384;
        float* x = pp->out + (long)qt * TQ * 1024;
        bf16* Hh = (bf16*)SB;
        char* SCR = SB + 32 * MiB;
        bf16* RQ = (bf16*)(SB + 72 * MiB);
        bf16* RK = (bf16*)(SB + 104 * MiB);
        bf16* RKTF = (bf16*)(SB + 136 * MiB);
        bf16* RKTB = (bf16*)(SB + 168 * MiB);
        bf16* RVT = (bf16*)(SB + 200 * MiB);
        bf16* OF = (bf16*)(SB + 264 * MiB);
        bf16* OB = (bf16*)(SB + 328 * MiB);
        phase_rmsnorm_bf16(x, pp->in[2] + L * 1024, Hh, TQ);
        gsync(bar_gen);
        gemm_phase(Hh, 1024, WQKV, 1024, 1024, 8 * 16, nb, lds, MAP_2D(16, 1024, 1024),
            [&](f32x16 (&acc)[4][2], int mw, int nw, int r, int h) {
              if (nw < 2048) {
                const int isk = nw >= 1024, n2 = nw & 1023, head = n2 >> 8, blk = (n2 & 255) >> 6;
                const float lgf = neg_softplus(pp->in[16][jl * 4 + head]), lgb = neg_softplus(pp->in[17][jl * 4 + head]);
                const int d1 = head * 256 + blk * 32 + r, d2 = d1 + 128;
                EPI_LOOP_PAIR {
                  const int t0 = mw + mi * 32 + g * 8 + h * 4;
                  float o1[4], o2[4];
#pragma unroll
                  for (int e = 0; e < 4; ++e) {
                    const float2 cs = tabR[(long)((t0 + e) & (S - 1)) * 128 + blk * 32 + r];
                    const float a = acc[mi][0][4 * g + e], b = acc[mi][1][4 * g + e];
                    o1[e] = a * cs.x - b * cs.y; o2[e] = a * cs.y + b * cs.x;
                  }
                  if (!isk) {
#pragma unroll
                    for (int e = 0; e < 4; ++e) { RQ[(long)(t0 + e) * 1024 + d1] = tobf(o1[e]); RQ[(long)(t0 + e) * 1024 + d2] = tobf(o2[e]); }
                  } else {
                    float f1[4], f2[4], b1[4], b2[4];
#pragma unroll
                    for (int e = 0; e < 4; ++e) {
                      o1[e] *= 0.0625f; o2[e] *= 0.0625f;
                      RK[(long)(t0 + e) * 1024 + d1] = tobf(o1[e]); RK[(long)(t0 + e) * 1024 + d2] = tobf(o2[e]);
                      const int jj = (t0 + e) & 127;
                      const float df = __expf(lgf * (float)(127 - jj)), db = __expf(lgb * (float)jj);
                      f1[e] = o1[e] * df; f2[e] = o2[e] * df; b1[e] = o1[e] * db; b2[e] = o2[e] * db;
                    }
                    u32x2 v;
                    v = (u32x2){pk2(f1[0], f1[1]), pk2(f1[2], f1[3])}; *(u32x2*)(RKTF + ((long)(t0 >> 7) * 1024 + d1) * 128 + (t0 & 127)) = v;
                    v = (u32x2){pk2(f2[0], f2[1]), pk2(f2[2], f2[3])}; *(u32x2*)(RKTF + ((long)(t0 >> 7) * 1024 + d2) * 128 + (t0 & 127)) = v;
                    v = (u32x2){pk2(b1[0], b1[1]), pk2(b1[2], b1[3])}; *(u32x2*)(RKTB + ((long)(t0 >> 7) * 1024 + d1) * 128 + (t0 & 127)) = v;
                    v = (u32x2){pk2(b2[0], b2[1]), pk2(b2[2], b2[3])}; *(u32x2*)(RKTB + ((long)(t0 >> 7) * 1024 + d2) * 128 + (t0 & 127)) = v;
                  }
                }
              } else {
                EPI_LOOP {
                  const int t0 = mw + mi * 32 + g * 8 + h * 4;
                  const int c = nw - 2048 + ni * 32 + r;
                  u32x2 o = {pk2(acc[mi][ni][4 * g], acc[mi][ni][4 * g + 1]), pk2(acc[mi][ni][4 * g + 2], acc[mi][ni][4 * g + 3])};
                  *(u32x2*)(RVT + ((long)(t0 >> 7) * 2048 + c) * 128 + (t0 & 127)) = o;
                }
              }
            });
        gsync(bar_gen);
        {
          for (int item = lbid(); item < 1024; item += nb) {
            const int dir = item & 1, head = (item >> 1) & 3, ck = item >> 3;
            const float lg = neg_softplus(pp->in[dir ? 17 : 16][jl * 4 + head]);
            ret_intra_item(RQ, RK, RVT, dir ? OB : OF, (bf16*)(SCR + (long)blockIdx.x * 163840), ck * 128, head, dir, lg, lds);
          }
          if (qt < 2) gsync(bar_gen);
          for (int pass = (qt >= 2 ? 0 : 1); pass < 2; ++pass) {
            for (int task = lbid(); task < 256; task += nb) {
              const int slice = task & 3, dir = (task >> 2) & 1, head = (task >> 3) & 3, u = task >> 5;
              if (pass == 0 && ((dir == 0 && u == 7) || (dir == 1 && u == 0))) continue;
              const float lg = neg_softplus(pp->in[dir ? 17 : 16][jl * 4 + head]);
              chain_task(RQ, dir ? RKTB : RKTF, RVT, dir ? OB : OF, (float*)(SCR + (long)task * 163840 + 32768), u * 2048, 16, head, dir, slice, lg, lds,
                         (pass == 1 && qt >= 2) ? 1 : 0, pass == 0 ? 1 : 0);
            }
            if (pass == 0) {
              gsync(bar_gen);
              phase_chain_combine(SCR, pp->in[16] + jl * 4, pp->in[17] + jl * 4);
              gsync(bar_gen);
            }
          }
        }
        gsync(bar_gen);
        phase_onorm(OF, OB, TQ);
        gsync(bar_gen);
        gemm_phase<true>(Hh, 1024, WG, 1024, 1024, 8 * 8, nb, lds, MAP_2D(8, 1024, 1024),
            [&](f32x16 (&acc)[4][2], int mw, int nw, int r, int h) {
#pragma unroll
              for (int mi = 0; mi < 4; ++mi) {
                unsigned t[16];
#pragma unroll
                for (int k = 0; k < 16; ++k) t[k] = *(const unsigned*)(OF + (long)(mw + mi * 32 + (k >> 2) * 8 + h * 4 + (k & 3)) * 2048 + nw + 2 * r);
#pragma unroll
                for (int k = 0; k < 16; ++k) {
                  const float g0 = acc[mi][0][k], g1 = acc[mi][1][k];
                  const float s0 = g0 / (1.f + __expf(-g0)), s1 = g1 / (1.f + __expf(-g1));
                  *(unsigned*)(OF + (long)(mw + mi * 32 + (k >> 2) * 8 + h * 4 + (k & 3)) * 2048 + nw + 2 * r) =
                      pk2(s0 * __uint_as_float(t[k] << 16), s1 * __uint_as_float(t[k] & 0xffff0000u));
                }
              }
            });
        gsync(bar_gen);
        gemm_phase<true>(OF, 2048, WOr, 2048, 2048, 8 * 4, nb, lds, MAP_STD(4, 2048, 2048),
            [&](f32x16 (&acc)[4][2], int mw, int nw, int r, int h) {
              epi_residual(acc, x, x, nullptr, mw, nw, r, h);
            });
        gsync(bar_gen);
      }
    } else {
      const bf16* WP = WB + WB_POOL;
      const float* psc = pp->in[19] + jl * 1024;
      for (int hf = 0; hf < 2; ++hf) {
        KP pp = kargs(); char* SB = pp->ws + OFF_S;
        const int S = hf ? 16384 : 2048;
        float* x = pp->out + (long)hf * TH * 1024;
        bf16* H = (bf16*)SB;
        bf16* PL = (bf16*)(SB + 64 * MiB);
        phase_rmsnorm_bf16(x, pp->in[2] + L * 1024, H, TH);
        gsync(bar_gen);
        phase_pool(H, PL, TH, S);
        gsync(bar_gen);
        gemm_phase<true>(PL, 1024, WP, 256, 256, 16 * 4, nb, lds,
            [&](int q_, long& ao, long& bo, int& mr, int& nc) { const int gq = TILE_TN(4); mr = TILE_TM(4) * 256; nc = gq * 256; ao = (long)mr * 1024 + gq * 256; bo = (long)gq * 65536; },
            [&](f32x16 (&acc)[4][2], int mw, int nw, int r, int h) {
              epi_residual(acc, x, x, psc, mw, nw, r, h);
            });
        gsync(bar_gen);
      }
    }
    {
      const bf16* W1 = WB + WB_MLP + (long)L * MLP_SZ;
      const bf16* W2 = W1 + MLP_W2;
      for (int hf = 0; hf < 2; ++hf) {
        KP pp = kargs(); char* SB = pp->ws + OFF_S;
        float* x = pp->out + (long)hf * TH * 1024;
        bf16* H = (bf16*)SB;
        bf16* HID = (bf16*)(SB + 64 * MiB);
        if (hf == 0) {
          phase_rmsnorm_bf16(x, pp->in[3] + L * 1024, H, TH);
          gsync(bar_gen);
        }
        gemm_phase<true>(H, 1024, W1, 1024, 1024, 16 * 16, nb, lds, MAP_2D(16, 1024, 1024),
            [&](f32x16 (&acc)[4][2], int mw, int nw, int r, int h) {
#pragma unroll
              for (int mi = 0; mi < 4; ++mi)
#pragma unroll
                for (int k = 0; k < 16; ++k) {
                  const float v0 = fmaxf(acc[mi][0][k], 0.f), v1 = fmaxf(acc[mi][1][k], 0.f);
                  *(unsigned*)(HID + (long)(mw + mi * 32 + (k >> 2) * 8 + h * 4 + (k & 3)) * 4096 + nw + 2 * r) = pk2(v0 * v0, v1 * v1);
                }
            });
        gsync(bar_gen);
        gemm_phase<true>(HID, 4096, W2, 4096, 4096, 16 * 4, nb, lds, MAP_STD(4, 4096, 4096),
            [&](f32x16 (&acc)[4][2], int mw, int nw, int r, int h) {
              epi_residual(acc, x, x, nullptr, mw, nw, r, h);
            });
        if (hf == 0) phase_rmsnorm_bf16(pp->out + (long)TH * 1024, pp->in[3] + L * 1024, H, TH);
        gsync(bar_gen);
      }
    }
  }
  phase_final_norm(pp->out, pp->in[22], T);
}

extern "C" void kernel_launch(void* const* d_in, const int* in_sizes, int n_in, void* d_out, int out_size, void* d_ws, size_t ws_size, hipStream_t stream) {
  static int grid_blocks = 0;
  if (!grid_blocks) {
    int dev = 0, cus = 0, per_cu = 0;
    hipGetDevice(&dev);
    hipDeviceGetAttribute(&cus, hipDeviceAttributeMultiprocessorCount, dev);
    hipOccupancyMaxActiveBlocksPerMultiprocessor(&per_cu, mega, NT, 0);
    if (per_cu > 1) per_cu = 1;
    grid_blocks = (cus * per_cu) & ~15;
    if (grid_blocks > 256) grid_blocks = 256;
    if (grid_blocks <= 0) { fprintf(stderr, "occupancy query failed\n"); grid_blocks = 256; }
  }
  Params p;
  memset(&p, 0, sizeof(p));
  for (int i = 0; i < 23 && i < n_in; ++i) p.in[i] = (const float*)d_in[i];
  p.out = (float*)d_out;
  p.ws = (char*)d_ws;
  int nj = 0;
  auto add = [&](const float* src, long long dst, int K, int N, int perm) { p.jobs[nj].src = src; p.jobs[nj].dst = dst; p.jobs[nj].K = K; p.jobs[nj].N = N; p.jobs[nj].perm = perm; p.jobs[nj].pad = 0; ++nj; };
  for (int j = 0; j < 2; ++j) {
    const long long base = j * MLA_SZ;
    add(p.in[4] + (long)j * 1024 * 384, base, 1024, 384, 0);
    add(p.in[7] + (long)j * 1024 * 320, base + 384L * 1024, 1024, 320, 0);
    add(p.in[6] + (long)j * 384 * 1536, base + MLA_WUQ, 384, 1536, 0);
    add(p.in[9] + (long)j * 256 * 2048, base + MLA_WUKV, 256, 2048, 0);
    add(p.in[10] + (long)j * 1024 * 1024, base + MLA_WO, 1024, 1024, 0);
  }
  add(p.in[11], WB_RET, 1024, 1024, 1);
  add(p.in[12], WB_RET + 1024L * 1024, 1024, 1024, 1);
  add(p.in[13], WB_RET + 2048L * 1024, 1024, 2048, 0);
  add(p.in[14], WB_RET + RET_WG, 1024, 2048, 0);
  add(p.in[15], WB_RET + RET_WO, 2048, 1024, 0);
  for (int g = 0; g < 4; ++g) add(p.in[18] + (long)g * 65536, WB_POOL + (long)g * 65536, 256, 256, 0);
  for (int i = 0; i < 4; ++i) {
    add(p.in[20] + (long)i * 1024 * 4096, WB_MLP + (long)i * MLP_SZ, 1024, 4096, 0);
    add(p.in[21] + (long)i * 4096 * 1024, WB_MLP + (long)i * MLP_SZ + MLP_W2, 4096, 1024, 0);
  }
  p.njobs = nj;
  hipMemsetAsync((char*)d_ws + OFF_BAR, 0, 16384, stream);
  void* args[] = {&p};
  hipError_t e = hipLaunchCooperativeKernel((void*)mega, dim3(grid_blocks), dim3(NT), args, 0, stream);
  if (e != hipSuccess) fprintf(stderr, "cooperative launch failed: %s (grid %d)\n", hipGetErrorString(e), grid_blocks);
}
```
